# Optimizing an MI355X kernel written in HIP

```python
import jax, jax.numpy as jnp
from jax import lax
import numpy as np

D_MODEL = 1024
BATCH = 8
SEQ = 2048
DEPTH = 4

GRID_W = 64
HEAD_DIM = 64
EPS = 1e-6
A_HEADS = D_MODEL // 256
A_PATTERNS = ((128, 1), (512, 4), (2048, 16))
A_ROT_DIM = HEAD_DIM // 4
ROPE_THETA = 500000.0
B_HEADS = D_MODEL // 256
B_DK = 128
B_DV = 128
B_CONV = 5
B_CHUNK = 64
C_Q_HEADS = D_MODEL // 256
C_KV_HEADS = C_Q_HEADS // 2
C_THETA = 10000.0
Q_BLOCK = 128
D_FF = (-(-(8 * D_MODEL) // (3 * 256))) * 256

SPLITS = (
    A_HEADS * HEAD_DIM, A_HEADS * HEAD_DIM, A_HEADS * HEAD_DIM,
    B_HEADS * B_DK, B_HEADS * B_DK, B_HEADS * B_DV, B_HEADS * B_DV,
    2 * B_HEADS, 2 * B_HEADS,
    C_Q_HEADS * HEAD_DIM, C_KV_HEADS * HEAD_DIM, C_KV_HEADS * HEAD_DIM,
)
IN_DIM = sum(SPLITS)
D_MIX = A_HEADS * HEAD_DIM + B_HEADS * B_DV + C_Q_HEADS * HEAD_DIM
B_QKV = 2 * B_HEADS * B_DK + B_HEADS * B_DV

kernel_name = 'hybrid_parallel_dilated_gdn_axialgqa_block'

F32 = jnp.float32


def rmsnorm(x, w):
    xf = x.astype(F32)
    y = xf * lax.rsqrt(jnp.mean(xf * xf, axis=-1, keepdims=True) + EPS)
    return (y * w.astype(F32)).astype(x.dtype)


def l2norm(x):
    return x * lax.rsqrt(jnp.sum(x * x, axis=-1, keepdims=True) + EPS)


def rope(x, pos, theta):
    half = x.shape[-1] // 2
    inv = jnp.float32(theta) ** (-jnp.arange(half, dtype=F32) / half)
    ang = pos.astype(F32)[:, None] * inv[None, :]
    cos = jnp.cos(ang)[None, :, None, :]
    sin = jnp.sin(ang)[None, :, None, :]
    xf = x.astype(F32)
    x1, x2 = xf[..., :half], xf[..., half:]
    return jnp.concatenate([x1 * cos - x2 * sin, x2 * cos + x1 * sin], axis=-1).astype(x.dtype)


def to_strided(t, d):
    b, s = t.shape[:2]
    rest = t.shape[2:]
    return t.reshape(b, s // d, d, *rest).swapaxes(1, 2).reshape(b * d, s // d, *rest)


def from_strided(t, d, b):
    n, L = t.shape[:2]
    rest = t.shape[2:]
    return t.reshape(b, d, L, *rest).swapaxes(1, 2).reshape(b, L * d, *rest)


def banded_attention(q, k, v, radius):
    n, L, h, dh = q.shape
    blk = radius
    nb = -(-L // blk)
    pad = nb * blk - L
    qb = jnp.pad(q, ((0, 0), (0, pad), (0, 0), (0, 0))).reshape(n, nb, blk, h, dh)
    padk = ((0, 0), (blk, pad + blk), (0, 0), (0, 0))
    kp = jnp.pad(k, padk).reshape(n, nb + 2, blk, h, dh)
    vp = jnp.pad(v, padk).reshape(n, nb + 2, blk, h, dh)
    kw = jnp.concatenate([kp[:, :-2], kp[:, 1:-1], kp[:, 2:]], axis=2)
    vw = jnp.concatenate([vp[:, :-2], vp[:, 1:-1], vp[:, 2:]], axis=2)
    qpos = jnp.arange(nb)[:, None] * blk + jnp.arange(blk)[None, :]
    kpos = (jnp.arange(nb)[:, None] - 1) * blk + jnp.arange(3 * blk)[None, :]
    dist = qpos[:, :, None] - kpos[:, None, :]
    kp_b = kpos[:, None, :]
    valid = ((jnp.abs(dist) <= radius) & (kp_b >= 0) & (kp_b < L)) | (dist == 0)
    sc = jnp.einsum('nbqhd,nbkhd->nbhqk', qb.astype(F32), kw.astype(F32)) * (dh ** -0.5)
    sc = jnp.where(valid[None, :, None], sc, -jnp.inf)
    m = jnp.max(sc, axis=-1, keepdims=True)
    p = jnp.exp(sc - m)
    l = jnp.sum(p, axis=-1, keepdims=True)
    o = jnp.einsum('nbhqk,nbkhd->nbqhd', p / l, vw.astype(F32)).reshape(n, nb * blk, h, dh)[:, :L]
    lse = (m + jnp.log(l))[..., 0].transpose(0, 1, 3, 2).reshape(n, nb * blk, h)[:, :L]
    return o, lse


def mixer_dilated(q, k, v, qn, kn, pos):
    b, s = q.shape[:2]
    q = rmsnorm(q.reshape(b, s, A_HEADS, HEAD_DIM), qn)
    k = rmsnorm(k.reshape(b, s, A_HEADS, HEAD_DIM), kn)
    v = v.reshape(b, s, A_HEADS, HEAD_DIM)
    q = jnp.concatenate([rope(q[..., :A_ROT_DIM], pos, ROPE_THETA), q[..., A_ROT_DIM:]], axis=-1)
    k = jnp.concatenate([rope(k[..., :A_ROT_DIM], pos, ROPE_THETA), k[..., A_ROT_DIM:]], axis=-1)
    outs, lses = [], []
    for window, dil in A_PATTERNS:
        radius = window // (2 * dil)
        o, lse = banded_attention(to_strided(q, dil), to_strided(k, dil), to_strided(v, dil), radius)
        outs.append(from_strided(o, dil, b))
        lses.append(from_strided(lse, dil, b))
    wts = jax.nn.softmax(jnp.stack(lses), axis=0)
    o = jnp.einsum('pbsh,pbshd->bshd', wts, jnp.stack(outs))
    return o.reshape(b, s, -1).astype(v.dtype)


def short_conv(x, w):
    kk, c = w.shape
    return lax.conv_general_dilated(
        x, w[:, None, :].astype(x.dtype), window_strides=(1,),
        padding=[(kk // 2, kk // 2)], dimension_numbers=('NWC', 'WIO', 'NWC'),
        feature_group_count=c)


def gated_delta_chunked(q, k, v, g, beta):
    b, s, h, dk = q.shape
    dv = v.shape[-1]
    c = B_CHUNK
    n = s // c
    to_c = lambda t: t.reshape(b, n, c, h, t.shape[-1]).transpose(1, 0, 3, 2, 4)
    q, k, v = to_c(q), to_c(k), to_c(v)
    g = g.reshape(b, n, c, h).transpose(1, 0, 3, 2)
    beta = beta.reshape(b, n, c, h).transpose(1, 0, 3, 2)
    gc = jnp.cumsum(g, axis=-1)
    tril = jnp.tril(jnp.ones((c, c), dtype=bool))
    decay = jnp.exp(jnp.where(tril, gc[..., :, None] - gc[..., None, :], -jnp.inf))
    kbeta = k * beta[..., None]
    eye = jnp.eye(c, dtype=F32)
    a_mat = jnp.einsum('nbhid,nbhjd->nbhij', kbeta, k) * decay * (1.0 - eye)
    rhs = jnp.concatenate([v * beta[..., None], kbeta * jnp.exp(gc)[..., None]], axis=-1)
    sol = lax.linalg.triangular_solve(a_mat + eye, rhs, left_side=True, lower=True)
    u, w = sol[..., :dv], sol[..., dv:]
    qk = jnp.einsum('nbhid,nbhjd->nbhij', q, k) * decay

    def step(state, xs):
        q_i, k_i, u_i, w_i, gc_i, qk_i = xs
        v_new = u_i - jnp.einsum('bhck,bhkv->bhcv', w_i, state)
        o = (jnp.einsum('bhck,bhkv->bhcv', q_i * jnp.exp(gc_i)[..., None], state)
             + jnp.einsum('bhij,bhjv->bhiv', qk_i, v_new))
        g_last = gc_i[..., -1:]
        state = (state * jnp.exp(g_last)[..., None]
                 + jnp.einsum('bhck,bhcv->bhkv', k_i * jnp.exp(g_last - gc_i)[..., None], v_new))
        return state, o

    state0 = jnp.zeros((b, h, dk, dv), F32)
    _, o = lax.scan(step, state0, (q, k, u, w, gc, qk))
    return o.transpose(1, 0, 3, 2, 4).reshape(b, s, h, dv)


def mixer_gdn(q, k, v, z, a, beta_in, conv_w, a_log, dt_bias, onorm):
    b, s = q.shape[:2]
    qkv = jax.nn.silu(short_conv(jnp.concatenate([q, k, v], axis=-1), conv_w)).astype(F32)
    q, k, v = jnp.split(qkv, [B_HEADS * B_DK, 2 * B_HEADS * B_DK], axis=-1)
    q = l2norm(q.reshape(b, s, B_HEADS, B_DK)) * (B_DK ** -0.5)
    k = l2norm(k.reshape(b, s, B_HEADS, B_DK))
    v = v.reshape(b, s, B_HEADS, B_DV)
    a = a.astype(F32).reshape(b, s, 2, B_HEADS)
    beta = jax.nn.sigmoid(beta_in.astype(F32).reshape(b, s, 2, B_HEADS))
    g = -jnp.exp(a_log.astype(F32)) * jax.nn.softplus(a + dt_bias.astype(F32))
    o_f = gated_delta_chunked(q, k, v, g[:, :, 0], beta[:, :, 0])
    flip = lambda t: jnp.flip(t, axis=1)
    o_b = flip(gated_delta_chunked(flip(q), flip(k), flip(v), flip(g[:, :, 1]), flip(beta[:, :, 1])))
    o = rmsnorm(o_f + o_b, onorm) * jax.nn.silu(z.astype(F32).reshape(b, s, B_HEADS, B_DV))
    return o.reshape(b, s, -1).astype(z.dtype)


def mixer_gqa(q, k, v, qn, kn, row_pos, col_pos):
    b, s = q.shape[:2]
    q = rmsnorm(q.reshape(b, s, C_Q_HEADS, HEAD_DIM), qn)
    k = rmsnorm(k.reshape(b, s, C_KV_HEADS, HEAD_DIM), kn)
    v = v.reshape(b, s, C_KV_HEADS, HEAD_DIM)
    half = HEAD_DIM // 2
    axial = lambda t: jnp.concatenate(
        [rope(t[..., :half], row_pos, C_THETA), rope(t[..., half:], col_pos, C_THETA)], axis=-1)
    q, k = axial(q), axial(k)
    grp = C_Q_HEADS // C_KV_HEADS
    nblk = s // Q_BLOCK
    qb = q.reshape(b, nblk, Q_BLOCK, C_KV_HEADS, grp, HEAD_DIM).transpose(1, 0, 2, 3, 4, 5).astype(F32)
    kf, vf = k.astype(F32), v.astype(F32)

    def block(qi):
        sc = jnp.einsum('bqhgd,bshd->bhgqs', qi, kf) * (HEAD_DIM ** -0.5)
        p = jax.nn.softmax(sc, axis=-1)
        return jnp.einsum('bhgqs,bshd->bqhgd', p, vf)

    o = lax.map(block, qb)
    return o.transpose(1, 0, 2, 3, 4, 5).reshape(b, s, -1).astype(v.dtype)


def setup_inputs(seed: int = 0) -> dict:
    key = jax.random.key(seed)
    ks = jax.random.split(key, 16)
    nrm = lambda k, shape, fan: jax.random.normal(k, shape, F32) * (fan ** -0.5)
    gain = lambda k, shape: 1.0 + 0.01 * jax.random.normal(k, shape, F32)
    dt = jnp.exp(jax.random.uniform(ks[7], (DEPTH, 2, B_HEADS), F32, np.log(1e-3), np.log(1e-1)))
    return {
        'x': jax.random.normal(ks[0], (BATCH, SEQ, D_MODEL), F32),
        'norm1': gain(ks[1], (DEPTH, D_MODEL)),
        'w_in': nrm(ks[2], (DEPTH, D_MODEL, IN_DIM), D_MODEL),
        'qn_a': gain(ks[3], (DEPTH, HEAD_DIM)),
        'kn_a': gain(ks[4], (DEPTH, HEAD_DIM)),
        'conv_b': nrm(ks[5], (DEPTH, B_CONV, B_QKV), B_CONV),
        'a_log_b': jnp.log(jax.random.uniform(ks[6], (DEPTH, 2, B_HEADS), F32, 1.0, 16.0)),
        'dt_bias_b': jnp.log(jnp.expm1(dt)),
        'onorm_b': gain(ks[8], (DEPTH, B_DV)),
        'qn_c': gain(ks[9], (DEPTH, HEAD_DIM)),
        'kn_c': gain(ks[10], (DEPTH, HEAD_DIM)),
        'w_out': nrm(ks[11], (DEPTH, D_MIX, D_MODEL), D_MIX),
        'norm2': gain(ks[12], (DEPTH, D_MODEL)),
        'w_gate_up': nrm(ks[13], (DEPTH, D_MODEL, 2 * D_FF), D_MODEL),
        'w_down': nrm(ks[14], (DEPTH, D_FF, D_MODEL), D_FF),
    }


def reference(x, norm1, w_in, qn_a, kn_a, conv_b, a_log_b, dt_bias_b, onorm_b, qn_c, kn_c,
              w_out, norm2, w_gate_up, w_down):
    s = x.shape[1]
    rows = s // GRID_W
    pos = jnp.arange(s)
    row_pos = jnp.repeat(jnp.arange(rows), GRID_W)
    col_pos = jnp.tile(jnp.arange(GRID_W), rows)
    cuts = np.cumsum(SPLITS)[:-1].tolist()
    for i in range(DEPTH):
        h = rmsnorm(x, norm1[i])
        (qa, ka, va, qb, kb, vb, zb, ab, bb, qc, kc, vc) = jnp.split(h @ w_in[i], cuts, axis=-1)
        o_a = mixer_dilated(qa, ka, va, qn_a[i], kn_a[i], pos)
        o_b = mixer_gdn(qb, kb, vb, zb, ab, bb, conv_b[i], a_log_b[i], dt_bias_b[i], onorm_b[i])
        o_c = mixer_gqa(qc, kc, vc, qn_c[i], kn_c[i], row_pos, col_pos)
        x = x + jnp.concatenate([o_a, o_b, o_c], axis=-1) @ w_out[i]
        gate, up = jnp.split(rmsnorm(x, norm2[i]) @ w_gate_up[i], 2, axis=-1)
        x = x + (jax.nn.silu(gate) * up) @ w_down[i]
    return x
```

```cpp
#include <hip/hip_runtime.h>
#include <hip/hip_cooperative_groups.h>
#include <cstdio>
#include <cstdint>
namespace cg = cooperative_groups;
namespace pg8 {
#define PG8_LAS __attribute__((address_space(3)))
typedef unsigned short bf16_t;
typedef short bf16x8 __attribute__((ext_vector_type(8)));
typedef float f32x4 __attribute__((ext_vector_type(4)));
typedef unsigned u32x4 __attribute__((ext_vector_type(4)));
constexpr int BM = 256, BK = 64, HALF = 128, HTB = HALF * BK * 2  , STAGE_BYTES = 8 * HTB, NXCD = 8, WGM = 8;

__host__ __device__ __forceinline__ int lds_byte(int r, int c) { const int st = (r >> 4) * 2 + (c >> 5), rr = r & 15, cc = c & 31, ob = rr * 64 + cc * 2; return st * 1024 + (ob ^ (((ob >> 9) & 1) << 5)); }
__host__ __device__ __forceinline__ void stage_rc(int b, int& R, int& C) { const int st = b / 1024, sb = b % 1024, swz = sb ^ (((sb >> 9) & 1) << 5); R = (st >> 1) * 16 + swz / 64; C = (st & 1) * 32 + (swz % 64) / 2; }
__host__ __device__ __forceinline__ int perm32(int rho) { const int n = rho >> 4, i = rho & 15; return 8 * (i >> 2) + 4 * n + (i & 3); }

struct Unit { int pm, pn; };
struct Gemm { const bf16_t* A; const bf16_t* Bt; int M, N, K; };

struct StaticOrder {
    int nM, nN, nwg, G, c;
    __host__ __device__ void init(int M, int N, int G_, int c_) { nM = M / BM; nN = N / BM; nwg = nM * nN; G = G_; c = c_; }
    __host__ __device__ bool next(int i, Unit& u) const {
        const long L = (long)i * G + c; if (L >= nwg) return false;
        int wgid = (int)L; { const int q = nwg / NXCD, r = nwg % NXCD, xcd = wgid % NXCD, off = wgid / NXCD; wgid = (xcd < r ? xcd * (q + 1) : r * (q + 1) + (xcd - r) * q) + off; }
        const int nig = WGM * nN, gid = wgid / nig, fm = gid * WGM, gsz = (nM - fm) < WGM ? (nM - fm) : WGM;
        u.pm = fm + ((wgid % nig) % gsz); u.pn = (wgid % nig) / gsz; return true;
    }
    __device__ __forceinline__ void a_ready(const Unit&) const {}
    __device__ __forceinline__ void done(const Unit&) const {}
};

__device__ __forceinline__ unsigned cvt_pk_bf16(float lo, float hi) { unsigned r; asm volatile("v_cvt_pk_bf16_f32 %0, %1, %2" : "=v"(r) : "v"(lo), "v"(hi)); return r; }
typedef float f32x2 __attribute__((ext_vector_type(2)));
__device__ __forceinline__ float silu_f(float x) { return x * __builtin_amdgcn_rcpf(1.0f + __expf(-x)); }
struct EpiStoreBf16 {
    static constexpr bool PERM = true, AFTER_DRAIN = false;
    bf16_t* O; int ldc;
    __device__ __forceinline__ void operator()(const f32x4 (&acc)[2][2][4][2], const Unit& u, int wr, int wc, int fr, int fq) const {
        const int row0 = u.pm * BM + wr * 64 + fr; const int col0 = u.pn * BM + wc * 32 + 8 * fq;
#pragma unroll
        for (int ai = 0; ai < 2; ++ai)
#pragma unroll
            for (int m = 0; m < 4; ++m) { bf16_t* rowp = O + (size_t)(row0 + ai * HALF + m * 16) * ldc + col0;
#pragma unroll
                for (int bj = 0; bj < 2; ++bj) { const f32x4 v0 = acc[ai][bj][m][0], v1 = acc[ai][bj][m][1];
                    u32x4 w; w.x = cvt_pk_bf16(v0[0], v0[1]); w.y = cvt_pk_bf16(v0[2], v0[3]); w.z = cvt_pk_bf16(v1[0], v1[1]); w.w = cvt_pk_bf16(v1[2], v1[3]);
                    *(u32x4*)(rowp + bj * HALF) = w; } }
    }
};
struct EpiSwiglu {
    static constexpr bool PERM = true, AFTER_DRAIN = false;
    bf16_t* O; int ldc;
    __device__ __forceinline__ void operator()(const f32x4 (&acc)[2][2][4][2], const Unit& u, int wr, int wc, int fr, int fq) const {
        const int row0 = u.pm * BM + wr * 64 + fr; const int col0 = u.pn * HALF + wc * 32 + 8 * fq;
#pragma unroll
        for (int ai = 0; ai < 2; ++ai)
#pragma unroll
            for (int m = 0; m < 4; ++m) { bf16_t* rowp = O + (size_t)(row0 + ai * HALF + m * 16) * ldc + col0;
                const f32x4 g0 = acc[ai][0][m][0], g1 = acc[ai][0][m][1], u0 = acc[ai][1][m][0], u1 = acc[ai][1][m][1];
                f32x4 a, b;
#pragma unroll
                for (int e = 0; e < 4; ++e) { a[e] = silu_f(g0[e]) * u0[e]; b[e] = silu_f(g1[e]) * u1[e]; }
                u32x4 w; w.x = cvt_pk_bf16(a[0], a[1]); w.y = cvt_pk_bf16(a[2], a[3]); w.z = cvt_pk_bf16(b[0], b[1]); w.w = cvt_pk_bf16(b[2], b[3]);
                *(u32x4*)rowp = w; }
    }
};
struct EpiResid {
    static constexpr bool PERM = false, AFTER_DRAIN = false;
    const float* res; float* out; int ldc;
    __device__ __forceinline__ void operator()(const f32x4 (&acc)[2][2][4][2], const Unit& u, int wr, int wc, int fr, int fq) const {
        const int row0 = u.pm * BM + wr * 64 + fr; const int col0 = u.pn * BM + wc * 32 + 4 * fq;
#pragma unroll
        for (int ai = 0; ai < 2; ++ai)
#pragma unroll
            for (int m = 0; m < 4; ++m) { const size_t off = (size_t)(row0 + ai * HALF + m * 16) * ldc + col0;
#pragma unroll
                for (int bj = 0; bj < 2; ++bj)
#pragma unroll
                    for (int n = 0; n < 2; ++n) { const f32x4 r = *(const f32x4*)(res + off + bj * HALF + n * 16); *(f32x4*)(out + off + bj * HALF + n * 16) = r + acc[ai][bj][m][n]; } }
    }
};
template <class Epi, class Sched, bool ALIGN_EPI = false, bool SP2 = false>
__device__ __forceinline__ void gemm_phase(PG8_LAS unsigned char* lds, const Gemm g, const Sched& S, const Epi& E) {
    int tid_ = threadIdx.x; asm volatile("" : "+v"(tid_)); const int tid = tid_, wid = __builtin_amdgcn_readfirstlane(tid >> 6), lane = tid & 63, wr = wid >> 2, wc = wid & 3, fr = lane & 15, fq = lane >> 4;
    const int K = g.K, nt = K / BK;
    unsigned voffA[2], voffB[2];
#pragma unroll
    for (int i = 0; i < 2; ++i) { int R, C; stage_rc(tid * 16 + i * 8192, R, C); const int Rb = Epi::PERM ? ((R & ~31) + perm32(R & 31)) : R;
        voffA[i] = (unsigned)(R * K + C) * 2u; voffB[i] = (unsigned)(Rb * K + C) * 2u; }
    const size_t kstep = (size_t)(BK * 2);
    const size_t hstep = (size_t)HALF * K * 2;
    const size_t tstep = 2 * hstep;
    const unsigned ldsw = (unsigned)wid * 1024u;
    const int aoff = lds_byte(wr * 64 + fr, fq * 8), boff = lds_byte(wc * 32 + fr, fq * 8);
#define PG8_SA(b, h) (((b) * 2 + (h)) * HTB)
#define PG8_SB(b, h) ((4 + (b) * 2 + (h)) * HTB)
#define PG8_STAGE(bufoff, gbase, voff) do { _Pragma("unroll") for (int _i = 0; _i < 2; ++_i) \
        __builtin_amdgcn_global_load_lds((const unsigned*)((const char*)(gbase) + (voff)[_i]), (PG8_LAS unsigned*)(lds + (bufoff) + ldsw + _i * 8192), 16, 0, 0); } while (0)
#define PG8_LDA(dst, b, h) do { _Pragma("unroll") for (int m = 0; m < 4; ++m) _Pragma("unroll") for (int k = 0; k < 2; ++k) dst[m][k] = *(const PG8_LAS bf16x8*)(lds + PG8_SA(b, h) + aoff + m * 2048 + k * 1024); } while (0)
#define PG8_LDB(dst, b, h) do { _Pragma("unroll") for (int n = 0; n < 2; ++n) _Pragma("unroll") for (int k = 0; k < 2; ++k) dst[n][k] = *(const PG8_LAS bf16x8*)(lds + PG8_SB(b, h) + boff + n * 2048 + k * 1024); } while (0)
#define PG8_MMA(ai, bj, At, Bt) do { __builtin_amdgcn_s_setprio(1); _Pragma("unroll") for (int m = 0; m < 4; ++m) _Pragma("unroll") for (int n = 0; n < 2; ++n) _Pragma("unroll") for (int k = 0; k < 2; ++k) \
        acc[ai][bj][m][n] = __builtin_amdgcn_mfma_f32_16x16x32_bf16(Bt[n][k], At[m][k], acc[ai][bj][m][n], 0, 0, 0); __builtin_amdgcn_s_setprio(0); } while (0)
#define PG8_WAIT_V(n) asm volatile("s_waitcnt vmcnt(" #n ")" ::: "memory")
#define PG8_WAIT_L(n) asm volatile("s_waitcnt lgkmcnt(" #n ")" ::: "memory")
#define PG8_BAR __builtin_amdgcn_s_barrier()
#define PG8_SCHED __builtin_amdgcn_sched_barrier(0)
    Unit cur, nxt; int ui = 0;
    if (!S.next(0, cur)) return;
    f32x4 acc[2][2][4][2];
#pragma unroll
    for (int a = 0; a < 2; ++a)
#pragma unroll
        for (int b = 0; b < 2; ++b)
#pragma unroll
            for (int m = 0; m < 4; ++m)
#pragma unroll
                for (int n = 0; n < 2; ++n) acc[a][b][m][n] = (f32x4){0.f, 0.f, 0.f, 0.f};
    bf16x8 At[4][2], B0[2][2], B1[2][2];
    const char* cA = (const char*)g.A + (size_t)cur.pm * tstep; const char* cB = (const char*)g.Bt + (size_t)cur.pn * tstep;
    S.a_ready(cur);
    if constexpr (SP2) {
        PG8_STAGE(PG8_SB(0, 0), cB, voffB); PG8_STAGE(PG8_SB(0, 1), cB + hstep, voffB); PG8_STAGE(PG8_SA(0, 0), cA, voffA); PG8_STAGE(PG8_SA(0, 1), cA + hstep, voffA);
        if (wr == 1) PG8_BAR;
        PG8_WAIT_V(2); PG8_BAR;
        PG8_STAGE(PG8_SB(1, 0), cB + kstep, voffB); PG8_STAGE(PG8_SA(1, 0), cA + kstep, voffA); PG8_STAGE(PG8_SB(1, 1), cB + hstep + kstep, voffB);
        PG8_WAIT_V(6); PG8_BAR;
    } else {
        PG8_STAGE(PG8_SB(0, 0), cB, voffB); PG8_STAGE(PG8_SA(0, 0), cA, voffA); PG8_STAGE(PG8_SB(0, 1), cB + hstep, voffB); PG8_STAGE(PG8_SA(0, 1), cA + hstep, voffA);
        if (wr == 1) PG8_BAR;
        PG8_WAIT_V(4); PG8_BAR;
        PG8_STAGE(PG8_SB(1, 0), cB + kstep, voffB); PG8_STAGE(PG8_SA(1, 0), cA + kstep, voffA); PG8_STAGE(PG8_SB(1, 1), cB + hstep + kstep, voffB);
        PG8_WAIT_V(6); PG8_BAR;
    }
    for (;;) {
        const bool has_next = S.next(ui + 1, nxt);
        const char* nA = has_next ? (const char*)g.A + (size_t)nxt.pm * tstep : cA; const char* nB = has_next ? (const char*)g.Bt + (size_t)nxt.pn * tstep : cB;
        for (int t = 0; t < nt; t += 2) {
            const bool last = (t == nt - 2);
            const char* a1 = cA + (size_t)(t + 1) * kstep;
            const char* a2 = last ? nA : cA + (size_t)(t + 2) * kstep; const char* b2 = last ? nB : cB + (size_t)(t + 2) * kstep;
            const char* a3 = a2 + kstep; const char* b3 = b2 + kstep;
            if (last && has_next) S.a_ready(nxt);
            if constexpr (SP2) {
            PG8_LDB(B0, 0, 0); PG8_LDB(B1, 0, 1); PG8_SCHED; PG8_LDA(At, 0, 0); PG8_STAGE(PG8_SA(1, 1), a1 + hstep, voffA);
            PG8_WAIT_V(8); PG8_WAIT_L(0); PG8_BAR; PG8_MMA(0, 0, At, B0); PG8_MMA(0, 1, At, B1); PG8_BAR; PG8_SCHED;
            PG8_LDA(At, 0, 1); PG8_STAGE(PG8_SB(0, 0), b2, voffB); PG8_STAGE(PG8_SB(0, 1), b2 + hstep, voffB); PG8_STAGE(PG8_SA(0, 0), a2, voffA);
            PG8_WAIT_V(8); PG8_WAIT_L(0); PG8_BAR; PG8_MMA(1, 0, At, B0); PG8_MMA(1, 1, At, B1); PG8_BAR; PG8_SCHED;
            PG8_LDB(B0, 1, 0); PG8_LDB(B1, 1, 1); PG8_SCHED; PG8_LDA(At, 1, 0); PG8_STAGE(PG8_SA(0, 1), a2 + hstep, voffA);
            PG8_WAIT_V(8); PG8_WAIT_L(0); PG8_BAR; PG8_MMA(0, 0, At, B0); PG8_MMA(0, 1, At, B1); PG8_BAR; PG8_SCHED;
            PG8_LDA(At, 1, 1); PG8_STAGE(PG8_SB(1, 0), b3, voffB); PG8_STAGE(PG8_SB(1, 1), b3 + hstep, voffB); PG8_STAGE(PG8_SA(1, 0), a3, voffA);
            PG8_WAIT_V(8); PG8_WAIT_L(0); PG8_BAR; PG8_MMA(1, 0, At, B0); PG8_MMA(1, 1, At, B1); PG8_BAR; PG8_SCHED;
            } else {
            PG8_LDB(B0, 0, 0); PG8_SCHED; PG8_LDA(At, 0, 0); PG8_STAGE(PG8_SA(1, 1), a1 + hstep, voffA);
            PG8_WAIT_L(8); PG8_BAR; PG8_WAIT_L(0); PG8_MMA(0, 0, At, B0); PG8_BAR; PG8_SCHED;
            PG8_LDB(B1, 0, 1); PG8_STAGE(PG8_SB(0, 0), b2, voffB);
            PG8_BAR; PG8_WAIT_L(0); PG8_MMA(0, 1, At, B1); PG8_BAR;
            PG8_LDA(At, 0, 1); PG8_STAGE(PG8_SA(0, 0), a2, voffA);
            PG8_BAR; PG8_WAIT_L(0); PG8_MMA(1, 0, At, B0); PG8_BAR; PG8_SCHED;
            PG8_STAGE(PG8_SB(0, 1), b2 + hstep, voffB);
            PG8_WAIT_V(6); PG8_BAR; PG8_MMA(1, 1, At, B1); PG8_BAR;
            PG8_LDB(B0, 1, 0); PG8_SCHED; PG8_LDA(At, 1, 0); PG8_STAGE(PG8_SA(0, 1), a2 + hstep, voffA);
            PG8_WAIT_L(8); PG8_BAR; PG8_WAIT_L(0); PG8_MMA(0, 0, At, B0); PG8_BAR; PG8_SCHED;
            PG8_LDB(B1, 1, 1); PG8_STAGE(PG8_SB(1, 0), b3, voffB);
            PG8_BAR; PG8_WAIT_L(0); PG8_MMA(0, 1, At, B1); PG8_BAR;
            PG8_LDA(At, 1, 1); PG8_STAGE(PG8_SA(1, 0), a3, voffA);
            PG8_BAR; PG8_WAIT_L(0); PG8_MMA(1, 0, At, B0); PG8_BAR; PG8_SCHED;
            PG8_STAGE(PG8_SB(1, 1), b3 + hstep, voffB);
            PG8_WAIT_V(6); PG8_BAR; PG8_MMA(1, 1, At, B1); PG8_BAR;
            }
        }
        if constexpr (ALIGN_EPI) { if (wr == 0) PG8_BAR; }
        if constexpr (!Epi::AFTER_DRAIN) { E(acc, cur, wr, wc, fr, fq); S.done(cur); }
        if (!has_next) break;
#pragma unroll
        for (int a = 0; a < 2; ++a)
#pragma unroll
            for (int b = 0; b < 2; ++b)
#pragma unroll
                for (int m = 0; m < 4; ++m)
#pragma unroll
                    for (int n = 0; n < 2; ++n) acc[a][b][m][n] = (f32x4){0.f, 0.f, 0.f, 0.f};
        cur = nxt; cA = nA; cB = nB; ++ui;
        if constexpr (ALIGN_EPI) { if (wr == 1) PG8_BAR; }
    }
    PG8_WAIT_V(0);
    if constexpr (!ALIGN_EPI) { if (wr == 0) PG8_BAR; }
    PG8_BAR;
    if constexpr (Epi::AFTER_DRAIN) { E.fused(acc, cur, wr, wc, fr, fq, lds, wid, lane); S.done(cur); }
#undef PG8_SA
#undef PG8_SB
#undef PG8_STAGE
#undef PG8_LDA
#undef PG8_LDB
#undef PG8_MMA
#undef PG8_WAIT_V
#undef PG8_WAIT_L
#undef PG8_BAR
#undef PG8_SCHED
}
}
typedef float f32x2_t __attribute__((ext_vector_type(2)));
#define LAS __attribute__((address_space(3)))
typedef unsigned short bf16;
typedef float f32x4 __attribute__((ext_vector_type(4)));
typedef unsigned u32x4 __attribute__((ext_vector_type(4)));
typedef unsigned u32x2 __attribute__((ext_vector_type(2)));

constexpr int BATCH = 8, SEQ = 2048, DM = 1024, DEPTH = 4, M = BATCH * SEQ;
constexpr int INDIM = 3344, NPROJ = 3328, DFF = 2816, NGU = 2 * DFF, NBQKV = 1536;
constexpr int PC_QA = 0, PC_KA = 256, PC_VA = 512, PC_QB = 768, PC_KB = 1280, PC_VB = 1792, PC_ZB = 2304, PC_QC = 2816, PC_KC = 3072, PC_VC = 3200;
constexpr float EPS = 1e-6f;
constexpr int NPH = 10;
constexpr int LDS_BYTES = 147456;

constexpr size_t WS_CTL = 0;
constexpr size_t WS_G = 65536;
constexpr size_t WS_BETA = WS_G + (size_t)M * 8 * 4;
constexpr size_t WS_WIN = WS_BETA + (size_t)M * 8 * 4;
constexpr size_t WS_WO = WS_WIN + (size_t)NPROJ * DM * 2;
constexpr size_t WS_WGU = WS_WO + (size_t)DM * DM * 2;
constexpr size_t WS_WD = WS_WGU + (size_t)NGU * DM * 2;
constexpr size_t WS_XN = WS_WD + (size_t)DM * DFF * 2;
constexpr size_t WS_PROJ = WS_XN + (size_t)M * DM * 2;
constexpr size_t WS_X1 = WS_PROJ + (size_t)M * NPROJ * 2;
constexpr size_t WS_NW = WS_X1;
constexpr size_t WS_QB = WS_X1 + (size_t)M * 512 * 4;
constexpr size_t WS_KB = WS_QB + (size_t)M * 512 * 2;
constexpr size_t WS_U = WS_XN;
constexpr size_t WS_VB = WS_X1 + (size_t)M * DM * 4;
constexpr size_t WS_MIX = WS_VB + (size_t)M * 512 * 2;
constexpr size_t WS_QKD = WS_MIX + (size_t)M * DM * 2;
constexpr size_t WS_GCL = WS_QKD + (size_t)2048 * 4096 * 2;
constexpr size_t WS_OF = WS_GCL + (size_t)2048 * 64 * 4;
constexpr size_t WS_OB = WS_OF + (size_t)M * 512 * 2;
constexpr size_t WS_VTA = WS_OB + (size_t)M * 512 * 2;
constexpr size_t WS_VTC = WS_VTA + (size_t)M * 256 * 2;
constexpr size_t WS_VT3 = WS_VTC + (size_t)M * 128 * 2;
constexpr size_t WS_END = WS_VT3 + (size_t)M * 256 * 2;

struct Params { const float* in[15]; float* out; unsigned char* ws; int ph_lo, ph_hi; };
enum { I_X = 0, I_NORM1, I_WIN, I_QNA, I_KNA, I_CONV, I_ALOG, I_DTB, I_ONORM, I_QNC, I_KNC, I_WOUT, I_NORM2, I_WGU, I_WD };

__device__ __forceinline__ float bf2f(unsigned v) { return __uint_as_float(v << 16); }
__device__ __forceinline__ float bflo(unsigned v) { return __uint_as_float(v << 16); }
__device__ __forceinline__ float bfhi(unsigned v) { return __uint_as_float(v & 0xffff0000u); }
__device__ __forceinline__ unsigned pk2(float lo, float hi) { unsigned r; asm("v_cvt_pk_bf16_f32 %0, %1, %2" : "=v"(r) : "v"(lo), "v"(hi)); return r; }
__device__ __forceinline__ unsigned f2bf(float f) { return pk2(f, f) & 0xffffu; }
template <int CTRL> __device__ __forceinline__ float dpp_add(float v) { return v + __int_as_float(__builtin_amdgcn_update_dpp(0, __float_as_int(v), CTRL, 0xf, 0xf, true)); }
__device__ __forceinline__ float wave_sum(float v) {
    v = dpp_add<0xB1>(v); v = dpp_add<0x4E>(v); v = dpp_add<0x141>(v); v = dpp_add<0x140>(v);
    { const auto r16 = __builtin_amdgcn_permlane16_swap(__float_as_uint(v), __float_as_uint(v), false, false); v = __uint_as_float(r16[0]) + __uint_as_float(r16[1]); }
    { const auto r32 = __builtin_amdgcn_permlane32_swap(__float_as_uint(v), __float_as_uint(v), false, false); v = __uint_as_float(r32[0]) + __uint_as_float(r32[1]); }
    return v;
}
#define LDS_WAIT() asm volatile("s_waitcnt lgkmcnt(0)" ::: "memory")

struct Ctx { int tid, lane, wave, gw, ngw; LAS unsigned char* lds; };

__device__ __forceinline__ void tr_item(const float* __restrict__ W, int ldw, int K, int src_col0, bf16* WT, int dst_row0, int kb, LAS float* scr, int lane) {
    const int k0 = 64 * kb;
#pragma unroll 8
    for (int i = 0; i < 32; ++i) { const int kk = 2 * i + (lane >> 5); scr[kk * 33 + (lane & 31)] = W[(size_t)(k0 + kk) * ldw + src_col0 + (lane & 31)]; }
    LDS_WAIT();
    const int c = lane & 7;
#pragma unroll
    for (int j = 0; j < 4; ++j) { const int n = (lane >> 3) + 8 * j; const LAS float* s = scr + (8 * c) * 33 + n;
        u32x4 o; o.x = pk2(s[0 * 33], s[1 * 33]); o.y = pk2(s[2 * 33], s[3 * 33]); o.z = pk2(s[4 * 33], s[5 * 33]); o.w = pk2(s[6 * 33], s[7 * 33]);
        *(u32x4*)(WT + (size_t)(dst_row0 + n) * K + k0 + 8 * c) = o; }
    LDS_WAIT();
}

__device__ __forceinline__ void convert_weights(const Params& P, const Ctx& C, int L) {
    LAS float* scr = (LAS float*)(C.lds + C.wave * 16384);
    unsigned char* ws = P.ws;
    const float* win = P.in[I_WIN] + (size_t)L * DM * INDIM;
    const float* wout = P.in[I_WOUT] + (size_t)L * DM * DM;
    const float* wgu = P.in[I_WGU] + (size_t)L * DM * NGU;
    const float* wd = P.in[I_WD] + (size_t)L * DFF * DM;
    constexpr int N_IN = 16 * (NPROJ / 32), N_OUT = 16 * (DM / 32), N_GU = 16 * (NGU / 32), N_D = (DFF / 64) * (DM / 32);
    for (int it = C.gw; it < N_IN + N_OUT + N_GU + N_D; it += C.ngw) {
        int r = it;
        if (r < N_IN) { const int kb = r / (NPROJ / 32), nb = r % (NPROJ / 32), d0 = 32 * nb; tr_item(win, INDIM, DM, d0 < 2816 ? d0 : d0 + 16, (bf16*)(ws + WS_WIN), d0, kb, scr, C.lane); continue; }
        r -= N_IN;
        if (r < N_OUT) { const int kb = r / 32, nb = r % 32; tr_item(wout, DM, DM, 32 * nb, (bf16*)(ws + WS_WO), 32 * nb, kb, scr, C.lane); continue; }
        r -= N_OUT;
        if (r < N_GU) { const int kb = r / (NGU / 32), sb = r % (NGU / 32), j0 = 32 * sb; const int isup = j0 >= DFF, j = isup ? j0 - DFF : j0;
            tr_item(wgu, NGU, DM, j0, (bf16*)(ws + WS_WGU), (j / 128) * 256 + isup * 128 + (j % 128), kb, scr, C.lane); continue; }
        r -= N_GU;
        { const int kb = r / 32, nb = r % 32; tr_item(wd, DM, DFF, 32 * nb, (bf16*)(ws + WS_WD), 32 * nb, kb, scr, C.lane); }
    }
}

template <bool WITH_AB>
__device__ __forceinline__ void norm_rows(const Params& P, const Ctx& C, int L, const float* x, const float* nw) {
    bf16* XN = (bf16*)(P.ws + WS_XN);
    const LAS float* wab = (const LAS float*)C.lds;
    constexpr int RB = 4;
    for (int m0 = C.gw; m0 < M; m0 += RB * C.ngw) {
        f32x4 v[RB][4]; float rs[RB];
#pragma unroll
        for (int j = 0; j < RB; ++j) { const int m = m0 + j * C.ngw < M ? m0 + j * C.ngw : m0; const f32x4* xr = (const f32x4*)(x + (size_t)m * DM) + C.lane;
#pragma unroll
            for (int q = 0; q < 4; ++q) v[j][q] = xr[64 * q]; }
#pragma unroll
        for (int j = 0; j < RB; ++j) { float s = 0.f;
#pragma unroll
            for (int q = 0; q < 4; ++q) s += (v[j][q].x * v[j][q].x + v[j][q].y * v[j][q].y) + (v[j][q].z * v[j][q].z + v[j][q].w * v[j][q].w);
            rs[j] = s; }
#pragma unroll
        for (int j = 0; j < RB; ++j) rs[j] = __builtin_amdgcn_rsqf(wave_sum(rs[j]) * (1.0f / DM) + EPS);
#pragma unroll
        for (int q = 0; q < 4; ++q) { const f32x4 w4 = ((const f32x4*)nw)[C.lane + 64 * q];
#pragma unroll
            for (int j = 0; j < RB; ++j) v[j][q] = v[j][q] * rs[j] * w4; }
#pragma unroll
        for (int j = 0; j < RB; ++j) { const int m = m0 + j * C.ngw; if (m < M) { u32x2* o8 = (u32x2*)(XN + (size_t)m * DM) + C.lane;
#pragma unroll
            for (int q = 0; q < 4; ++q) { u32x2 o; o.x = pk2(v[j][q].x, v[j][q].y); o.y = pk2(v[j][q].z, v[j][q].w); o8[64 * q] = o; } } }
        if constexpr (WITH_AB) {
            float mine[RB];
#pragma unroll
            for (int j = 0; j < RB; ++j) mine[j] = 0.f;
#pragma unroll 2
            for (int c = 0; c < 16; ++c) {
                f32x2_t a2[RB];
#pragma unroll
                for (int j = 0; j < RB; ++j) a2[j] = (f32x2_t){0.f, 0.f};
#pragma unroll
                for (int q = 0; q < 4; ++q) { const f32x4 w4 = *(const LAS f32x4*)(wab + c * 1024 + 4 * C.lane + 256 * q);
#pragma unroll
                    for (int j = 0; j < RB; ++j) { a2[j] += (f32x2_t){v[j][q].x, v[j][q].y} * (f32x2_t){w4.x, w4.y}; a2[j] += (f32x2_t){v[j][q].z, v[j][q].w} * (f32x2_t){w4.z, w4.w}; } }
#pragma unroll
                for (int j = 0; j < RB; ++j) { const float a = wave_sum(a2[j].x + a2[j].y); if (C.lane == c) mine[j] = a; }
            }
#pragma unroll
            for (int j = 0; j < RB; ++j) { const int m = m0 + j * C.ngw; if (m < M) {
                if (C.lane < 8) {
                    const float al = P.in[I_ALOG][L * 8 + C.lane], dtb = P.in[I_DTB][L * 8 + C.lane];
                    const float xx = mine[j] + dtb; const float sp = xx > 20.f ? xx : log1pf(expf(xx));
                    ((float*)(P.ws + WS_G))[(size_t)m * 8 + C.lane] = -expf(al) * sp;
                } else if (C.lane < 16) {
                    ((float*)(P.ws + WS_BETA))[(size_t)m * 8 + C.lane - 8] = 1.0f / (1.0f + expf(-mine[j]));
                } } }
        }
    }
}

__device__ __forceinline__ void phase_n1(const Params& P, const Ctx& C, int L) {
    convert_weights(P, C, L);
    __syncthreads();
    {
        const float* win = P.in[I_WIN] + (size_t)L * DM * INDIM + 2816;
        LAS float* wab = (LAS float*)C.lds;
        for (int e = C.tid; e < 16 * 1024; e += 512) { const int k = e >> 4, c = e & 15; wab[c * 1024 + k] = win[(size_t)k * INDIM + c]; }
    }
    __syncthreads();
    const float* x = L == 0 ? P.in[I_X] : P.out;
    norm_rows<true>(P, C, L, x, P.in[I_NORM1] + L * DM);
    __syncthreads();
}

__device__ __forceinline__ void phase_prep(const Params& P, const Ctx& C, int L) {
    bf16* PROJ = (bf16*)(P.ws + WS_PROJ);
    bf16* QB = (bf16*)(P.ws + WS_QB); bf16* KB = (bf16*)(P.ws + WS_KB); bf16* VB = (bf16*)(P.ws + WS_VB);
    const int lane = C.lane;
    const float qna = P.in[I_QNA][L * 64 + lane], kna = P.in[I_KNA][L * 64 + lane], qnc = P.in[I_QNC][L * 64 + lane], knc = P.in[I_KNC][L * 64 + lane];
    const float invA = exp2f(-(float)(lane & 7) * (1.0f / 8.0f) * 18.931568569324174f);
    const float invC = exp2f(-(float)(lane & 15) * (1.0f / 16.0f) * 13.287712379549449f);
    const float* cw = P.in[I_CONV] + (size_t)L * 5 * NBQKV;
    for (int tb = C.gw; tb < M / 8; tb += C.ngw) {
      const int tokb = tb * 8, tbt = tokb & (SEQ - 1);
#pragma unroll 1
      for (int jb = 0; jb < 8; jb += 4) {
        unsigned xa4[4][8], xc4[4][6];
#pragma unroll
        for (int jj = 0; jj < 4; ++jj) { const bf16* prl = PROJ + (size_t)(tokb + jb + jj) * NPROJ;
#pragma unroll
            for (int v = 0; v < 8; ++v) xa4[jj][v] = prl[(v < 4 ? PC_QA : PC_KA) + (v & 3) * 64 + lane];
#pragma unroll
            for (int v = 0; v < 6; ++v) xc4[jj][v] = prl[(v < 4 ? PC_QC + v * 64 : PC_KC + (v - 4) * 64) + lane]; }
#pragma unroll
       for (int jj = 0; jj < 4; ++jj) {
        const int j = jb + jj;
        const int tok = tokb + j, t = tbt + j;
        bf16* pr = PROJ + (size_t)tok * NPROJ;
        unsigned xa[8], xc[6];
#pragma unroll
        for (int v = 0; v < 8; ++v) xa[v] = xa4[jj][v];
#pragma unroll
        for (int v = 0; v < 6; ++v) xc[v] = xc4[jj][v];
        float sA, cA;
        { float rev = (float)t * invA * 0.15915494309189535f; rev -= floorf(rev); sA = __builtin_amdgcn_sinf(rev); cA = __builtin_amdgcn_cosf(rev); }
        float ssa[8];
#pragma unroll
        for (int v = 0; v < 8; ++v) { const float x = bf2f(xa[v]); ssa[v] = wave_sum(x * x); }
#pragma unroll
        for (int v = 0; v < 8; ++v) {
            float y = bf2f(xa[v]) * (__builtin_amdgcn_rsqf(ssa[v] * (1.0f / 64.0f) + EPS)) * (v < 4 ? qna : kna);
            const float pa = __int_as_float(__builtin_amdgcn_update_dpp(0, __float_as_int(y), 0x128, 0xf, 0xf, true));
            if (lane < 8) y = y * cA - pa * sA; else if (lane < 16) y = y * cA + pa * sA;
            if (v < 4) y *= 0.18033688011112042f;
            pr[(v < 4 ? PC_QA : PC_KA) + (v & 3) * 64 + lane] = (bf16)f2bf(y);
        }
        float sC, cC;
        { const float pos = lane < 32 ? (float)(t >> 6) : (float)(t & 63); float rev = pos * invC * 0.15915494309189535f; rev -= floorf(rev); sC = __builtin_amdgcn_sinf(rev); cC = __builtin_amdgcn_cosf(rev); }
        float ssc[6];
#pragma unroll
        for (int v = 0; v < 6; ++v) { const float x = bf2f(xc[v]); ssc[v] = wave_sum(x * x); }
#pragma unroll
        for (int v = 0; v < 6; ++v) {
            float y = bf2f(xc[v]) * (__builtin_amdgcn_rsqf(ssc[v] * (1.0f / 64.0f) + EPS)) * (v < 4 ? qnc : knc);
            const float pa = __shfl_xor(y, 16);
            if ((lane & 16) == 0) y = y * cC - pa * sC; else y = y * cC + pa * sC;
            if (v < 4) y *= 0.18033688011112042f;
            pr[(v < 4 ? PC_QC + v * 64 : PC_KC + (v - 4) * 64) + lane] = (bf16)f2bf(y);
        }
       }
      }
#pragma unroll 1
      for (int part = 0; part < 3; ++part) {
        const bf16* src = PROJ + PC_QB + part * 512 + 2 * lane;
        f32x2_t w2[4][5]; unsigned rows[12][4];
#pragma unroll
        for (int h = 0; h < 4; ++h)
#pragma unroll
            for (int d = 0; d < 5; ++d) w2[h][d] = *(const f32x2_t*)(cw + d * NBQKV + part * 512 + h * 128 + 2 * lane);
#pragma unroll
        for (int rr = 0; rr < 12; ++rr) { const int tt = tbt + rr - 2;
#pragma unroll
            for (int h = 0; h < 4; ++h) rows[rr][h] = (tt >= 0 && tt < SEQ) ? *(const unsigned*)(src + (size_t)(tokb + rr - 2) * NPROJ + h * 128) : 0u; }
        bf16* dst = (part == 0 ? QB : (part == 1 ? KB : VB)) + 2 * lane;
#pragma unroll
        for (int j = 0; j < 8; ++j) {
            float a0[4], a1[4], ss[4];
#pragma unroll
            for (int h = 0; h < 4; ++h) { f32x2_t xx = (f32x2_t){0.f, 0.f};
#pragma unroll
                for (int d = 0; d < 5; ++d) xx += w2[h][d] * (f32x2_t){bflo(rows[j + d][h]), bfhi(rows[j + d][h])};
                const float x0 = xx.x, x1 = xx.y;
                a0[h] = x0 * __builtin_amdgcn_rcpf(1.0f + __expf(-x0)); a1[h] = x1 * __builtin_amdgcn_rcpf(1.0f + __expf(-x1)); ss[h] = a0[h] * a0[h] + a1[h] * a1[h]; }
            if (part < 2) {
#pragma unroll
                for (int h = 0; h < 4; ++h) ss[h] = wave_sum(ss[h]);
#pragma unroll
                for (int h = 0; h < 4; ++h) { float sc = __builtin_amdgcn_rsqf(ss[h] + EPS); if (part == 0) sc *= 0.08838834764831845f; a0[h] *= sc; a1[h] *= sc; } }
#pragma unroll
            for (int h = 0; h < 4; ++h) *(unsigned*)(dst + (size_t)(tokb + j) * 512 + h * 128) = pk2(a0[h], a1[h]);
        }
      }
    }
    {   LAS bf16* scr = (LAS bf16*)(C.lds + C.wave * 16384);
        for (int it = C.gw; it < BATCH * 6 * 32 + BATCH * 4 * 16 * 2; it += C.ngw) {
            const bf16* src; bf16* dst; size_t rstep = NPROJ, dstep = SEQ;
            if (it < BATCH * 6 * 32) { const int b = it / 192, hs = (it / 32) % 6, tb = it & 31;
                src = PROJ + ((size_t)b * SEQ + tb * 64) * NPROJ + (hs < 4 ? PC_VA + 64 * hs : PC_VC + 64 * (hs - 4)) + lane;
                dst = (hs < 4 ? (bf16*)(P.ws + WS_VTA) + ((size_t)(b * 4 + hs) * 64) * SEQ : (bf16*)(P.ws + WS_VTC) + ((size_t)(b * 2 + hs - 4) * 64) * SEQ) + tb * 64 + lane;
            } else { const int idx = it - BATCH * 6 * 32, b = idx >> 7, h = (idx >> 5) & 3, rr = (idx >> 1) & 15, half = idx & 1;
                src = PROJ + ((size_t)b * SEQ + rr + 16 * 64 * half) * NPROJ + PC_VA + 64 * h + lane; rstep = (size_t)16 * NPROJ;
                dst = (bf16*)(P.ws + WS_VT3) + ((size_t)((b * 4 + h) * 16 + rr) * 64) * 128 + half * 64 + lane; dstep = 128; }
#pragma unroll 8
            for (int i = 0; i < 64; ++i) scr[i * 66 + lane] = src[(size_t)i * rstep];
            LDS_WAIT();
#pragma unroll 8
            for (int d = 0; d < 64; ++d) dst[(size_t)d * dstep] = scr[lane * 66 + d];
            LDS_WAIT(); }
    }
}

#define LDS_BARRIER() do { asm volatile("s_waitcnt lgkmcnt(0)" ::: "memory"); __builtin_amdgcn_s_barrier(); asm volatile("" ::: "memory"); } while (0)
typedef short bf16x8_t __attribute__((ext_vector_type(8)));
typedef float f32x16_t __attribute__((ext_vector_type(16)));
typedef short s16x4_t __attribute__((ext_vector_type(4)));
__device__ __forceinline__ unsigned cvtpk(float lo, float hi) { unsigned r; asm volatile("v_cvt_pk_bf16_f32 %0, %1, %2" : "=v"(r) : "v"(lo), "v"(hi)); return r; }
template <int R0, int NR> __device__ __forceinline__ void b1_rows(f32x2_t (&sol)[32], const LAS float* Ar) {
#pragma unroll
    for (int ip = (R0 < 1 ? 1 : R0); ip < R0 + NR; ++ip) { f32x2_t a01 = (f32x2_t){0.f, 0.f}, a23 = (f32x2_t){0.f, 0.f};
#pragma unroll
        for (int j4 = 0; j4 < (ip + 3) / 4; ++j4) { const f32x4 a4 = *(const LAS f32x4*)(Ar + ip * 64 + 4 * j4);
            a01 -= (f32x2_t){a4.x, a4.y} * sol[2 * j4]; a23 -= (f32x2_t){a4.z, a4.w} * sol[2 * j4 + 1]; }
        const f32x2_t a = a01 + a23;
        sol[ip >> 1][ip & 1] += a.x + a.y; }
}
__device__ __forceinline__ void b1_item(const Params& P, const Ctx& C, int item) {
    const int b = item >> 7, c = (item >> 2) & 31, h = item & 3;
    int tid_ = C.tid; asm volatile("" : "+v"(tid_)); const int tid = tid_, lane = tid_ & 63;
    LAS unsigned char* L = C.lds;
    LAS unsigned char* Ks = L; LAS unsigned char* Qs = L + 17408;
    LAS float* KKf = (LAS float*)(L + 34816); LAS float* QKf = (LAS float*)(L + 51456);
    LAS float* gcl = (LAS float*)(L + 68096); LAS float* bel = gcl + 128;
    LAS float* Ad = (LAS float*)(L + 69120);
    const bf16* QB = (const bf16*)(P.ws + WS_QB); const bf16* KB = (const bf16*)(P.ws + WS_KB); const bf16* VB = (const bf16*)(P.ws + WS_VB);
    const float* G = (const float*)(P.ws + WS_G); const float* BETA = (const float*)(P.ws + WS_BETA);
    const size_t tok0 = (size_t)b * SEQ + c * 64;
#pragma unroll
    for (int m = 0; m < 2; ++m) { const int e = tid + 512 * m, r = e >> 4, p = e & 15;
        *(LAS u32x4*)(Ks + r * 272 + p * 16) = *(const u32x4*)(KB + (tok0 + r) * 512 + h * 128 + p * 8);
        *(LAS u32x4*)(Qs + r * 272 + p * 16) = *(const u32x4*)(QB + (tok0 + r) * 512 + h * 128 + p * 8); }
    u32x4 vpre[2];
#pragma unroll
    for (int m = 0; m < 2; ++m) { const int e = tid + 512 * m, r = e >> 4, p = e & 15; vpre[m] = *(const u32x4*)(VB + (tok0 + r) * 512 + h * 128 + p * 8); }
    if (tid < 128) { const int dir = tid >> 6, i = dir ? 63 - lane : lane; const size_t tok = tok0 + i;
        float g = G[tok * 8 + dir * 4 + h];
#pragma unroll
        for (int o = 1; o < 64; o <<= 1) { const float t = __shfl_up(g, o); if (lane >= o) g += t; }
        gcl[dir * 64 + lane] = g; bel[dir * 64 + lane] = BETA[tok * 8 + dir * 4 + h]; }
    LDS_BARRIER();
    { const int prod = C.wave >> 2, ti = (C.wave >> 1) & 1, tj = C.wave & 1, r = lane & 31, hh = lane >> 5;
      f32x16_t acc;
#pragma unroll
      for (int e = 0; e < 16; ++e) acc[e] = 0.f;
      const LAS unsigned char* Ab = (prod ? Qs : Ks) + (32 * ti + r) * 272 + hh * 16; const LAS unsigned char* Bb = Ks + (32 * tj + r) * 272 + hh * 16;
#pragma unroll
      for (int ks = 0; ks < 8; ++ks) { const bf16x8_t a = *(const LAS bf16x8_t*)(Ab + ks * 32), bb = *(const LAS bf16x8_t*)(Bb + ks * 32); acc = __builtin_amdgcn_mfma_f32_32x32x16_bf16(a, bb, acc, 0, 0, 0); }
      LAS float* dst = prod ? QKf : KKf;
#pragma unroll
      for (int e = 0; e < 16; ++e) dst[(32 * ti + (e & 3) + 8 * (e >> 2) + 4 * hh) * 65 + 32 * tj + r] = acc[e]; }
    LDS_BARRIER();
#pragma unroll
    for (int m = 0; m < 2; ++m) { const int e = tid + 512 * m, r = e >> 4, p = e & 15; *(LAS u32x4*)(Qs + r * 272 + p * 16) = vpre[m]; }
    const int dir = C.wave >> 2, t = tid & 255;
    const int cs = (dir ? 31 - c : c) * 64 + ((b * 4 + h) * 2 + dir);
    { bf16* qkd = (bf16*)(P.ws + WS_QKD) + (size_t)cs * 4096;
#pragma unroll 2
      for (int n = 0; n < 8; ++n) { const int e = 2 * (t + 256 * n), ip = e >> 6, jp = e & 63, i = dir ? 63 - ip : ip; float qv[2];
#pragma unroll
          for (int c2 = 0; c2 < 2; ++c2) { const int jq = jp + c2, j = dir ? 63 - jq : jq;
              const float dec = jq <= ip ? __expf(gcl[dir * 64 + ip] - gcl[dir * 64 + jq]) : 0.f;
              Ad[dir * 4096 + ip * 64 + jq] = jq < ip ? bel[dir * 64 + ip] * KKf[i * 65 + j] * dec : 0.f;
              qv[c2] = QKf[i * 65 + j] * dec; }
          *(unsigned*)(qkd + ip * 64 + jp) = pk2(qv[0], qv[1]); }
      if (t < 64) ((float*)(P.ws + WS_GCL))[(size_t)cs * 64 + t] = gcl[dir * 64 + t]; }
    LDS_BARRIER();
    { f32x2_t sol[32];
      const LAS float* gd = gcl + dir * 64; const LAS float* bd = bel + dir * 64;
      const int rstep = dir ? -272 : 272;
      if (t < 128) { const LAS unsigned char* vp = Qs + (dir ? 63 * 272 : 0) + t * 2;
#pragma unroll
          for (int ip = 0; ip < 64; ++ip) sol[ip >> 1][ip & 1] = bf2f(*(const LAS bf16*)(vp + ip * rstep)) * bd[ip];
      } else { const LAS unsigned char* kp = Ks + (dir ? 63 * 272 : 0) + (t - 128) * 2;
#pragma unroll
          for (int ip = 0; ip < 64; ++ip) sol[ip >> 1][ip & 1] = bf2f(*(const LAS bf16*)(kp + ip * rstep)) * bd[ip] * __expf(gd[ip]);
      }
      const LAS float* Ar = Ad + dir * 4096;
#pragma unroll 1
      for (int rb = 0; rb < 32; ++rb) {
          switch (rb) {
          case 0: b1_rows<0, 2>(sol, Ar); break;
          case 1: b1_rows<2, 2>(sol, Ar); break;
          case 2: b1_rows<4, 2>(sol, Ar); break;
          case 3: b1_rows<6, 2>(sol, Ar); break;
          case 4: b1_rows<8, 2>(sol, Ar); break;
          case 5: b1_rows<10, 2>(sol, Ar); break;
          case 6: b1_rows<12, 2>(sol, Ar); break;
          case 7: b1_rows<14, 2>(sol, Ar); break;
          case 8: b1_rows<16, 2>(sol, Ar); break;
          case 9: b1_rows<18, 2>(sol, Ar); break;
          case 10: b1_rows<20, 2>(sol, Ar); break;
          case 11: b1_rows<22, 2>(sol, Ar); break;
          case 12: b1_rows<24, 2>(sol, Ar); break;
          case 13: b1_rows<26, 2>(sol, Ar); break;
          case 14: b1_rows<28, 2>(sol, Ar); break;
          case 15: b1_rows<30, 2>(sol, Ar); break;
          case 16: b1_rows<32, 2>(sol, Ar); break;
          case 17: b1_rows<34, 2>(sol, Ar); break;
          case 18: b1_rows<36, 2>(sol, Ar); break;
          case 19: b1_rows<38, 2>(sol, Ar); break;
          case 20: b1_rows<40, 2>(sol, Ar); break;
          case 21: b1_rows<42, 2>(sol, Ar); break;
          case 22: b1_rows<44, 2>(sol, Ar); break;
          case 23: b1_rows<46, 2>(sol, Ar); break;
          case 24: b1_rows<48, 2>(sol, Ar); break;
          case 25: b1_rows<50, 2>(sol, Ar); break;
          case 26: b1_rows<52, 2>(sol, Ar); break;
          case 27: b1_rows<54, 2>(sol, Ar); break;
          case 28: b1_rows<56, 2>(sol, Ar); break;
          case 29: b1_rows<58, 2>(sol, Ar); break;
          case 30: b1_rows<60, 2>(sol, Ar); break;
          case 31: b1_rows<62, 2>(sol, Ar); break;
          default: break; }
      }
      LDS_BARRIER();
      LAS unsigned char* img = L + 34816 + dir * 32768;
      const float sg = t < 128 ? 1.f : -1.f;
#pragma unroll
      for (int ip = 0; ip < 64; ++ip) *(LAS bf16*)(img + ip * 512 + t * 2) = (bf16)f2bf(sg * sol[ip >> 1][ip & 1]); }
    LDS_BARRIER();
    { const LAS unsigned char* img = L + 34816 + dir * 32768;
      bf16* Ud = (bf16*)(P.ws + WS_U) + (size_t)cs * 8192; bf16* Nd = (bf16*)(P.ws + WS_NW) + (size_t)cs * 8192;
#pragma unroll
      for (int m = 0; m < 8; ++m) { const int e = t + 256 * m, row = e >> 5, p = e & 31; const u32x4 w = *(const LAS u32x4*)(img + row * 512 + p * 16);
          *(u32x4*)((p < 16 ? Ud : Nd) + row * 128 + (p & 15) * 8) = w; } }
    LDS_BARRIER();
}

constexpr int B2_NW = 0, B2_QG = 17408, B2_QK = 34816, B2_KGT = 44032, B2_EGL = 62464, B2_BUF = 62976;
struct B2Regs { u32x4 nw[2], qk, qv[2], kv[2]; float gq[2], gk, glast; };
__device__ __forceinline__ void b2_load(const Params& P, int chain, int n, int tid_, B2Regs& R) {
    int tid = tid_; asm volatile("" : "+v"(tid));
    const int b = chain >> 3, h = (chain >> 1) & 3, dir = chain & 1, cs = n * 64 + chain, c = dir ? 31 - n : n;
    const size_t tok0 = (size_t)b * SEQ + c * 64;
    const float* gcl = (const float*)(P.ws + WS_GCL) + (size_t)cs * 64;
    const bf16* NWg = (const bf16*)(P.ws + WS_NW) + (size_t)cs * 8192; const bf16* QKg = (const bf16*)(P.ws + WS_QKD) + (size_t)cs * 4096;
    const bf16* QB = (const bf16*)(P.ws + WS_QB); const bf16* KB = (const bf16*)(P.ws + WS_KB);
#pragma unroll
    for (int m = 0; m < 2; ++m) R.nw[m] = *(const u32x4*)(NWg + (tid + 512 * m) * 8);
    R.qk = *(const u32x4*)(QKg + tid * 8);
#pragma unroll
    for (int m = 0; m < 2; ++m) { const int e = tid + 512 * m, ip = e >> 4, p = e & 15, i = dir ? 63 - ip : ip; R.qv[m] = *(const u32x4*)(QB + (tok0 + i) * 512 + h * 128 + p * 8); R.gq[m] = gcl[ip]; }
#pragma unroll
    for (int m = 0; m < 2; ++m) { const int e = tid + 512 * m, ip = e & 63, p = e >> 6, i = dir ? 63 - ip : ip; R.kv[m] = *(const u32x4*)(KB + (tok0 + i) * 512 + h * 128 + p * 8); }
    R.gk = gcl[tid & 63]; R.glast = gcl[63];
}
__device__ __forceinline__ void b2_write(const B2Regs& R, LAS unsigned char* buf, int tid_) {
    int tid = tid_; asm volatile("" : "+v"(tid));
#pragma unroll
    for (int m = 0; m < 2; ++m) { const int e = tid + 512 * m, r = e >> 4, p = e & 15; *(LAS u32x4*)(buf + B2_NW + r * 272 + p * 16) = R.nw[m]; }
    { const int r = tid >> 3, p = tid & 7; *(LAS u32x4*)(buf + B2_QK + r * 144 + p * 16) = R.qk; }
#pragma unroll
    for (int m = 0; m < 2; ++m) { const int e = tid + 512 * m, ip = e >> 4, p = e & 15; const u32x4 q = R.qv[m]; const float s = __expf(R.gq[m]);
        u32x4 o; o.x = cvtpk(bflo(q.x) * s, bfhi(q.x) * s); o.y = cvtpk(bflo(q.y) * s, bfhi(q.y) * s); o.z = cvtpk(bflo(q.z) * s, bfhi(q.z) * s); o.w = cvtpk(bflo(q.w) * s, bfhi(q.w) * s);
        *(LAS u32x4*)(buf + B2_QG + ip * 272 + p * 16) = o; }
    const float sk = __expf(R.glast - R.gk);
#pragma unroll
    for (int m = 0; m < 2; ++m) { const int e = tid + 512 * m, ip = e & 63, p = e >> 6; const u32x4 k = R.kv[m];
        LAS bf16* d = (LAS bf16*)(buf + B2_KGT) + (8 * p) * 72 + ip;
        d[0] = (bf16)f2bf(bflo(k.x) * sk); d[72] = (bf16)f2bf(bfhi(k.x) * sk); d[144] = (bf16)f2bf(bflo(k.y) * sk); d[216] = (bf16)f2bf(bfhi(k.y) * sk);
        d[288] = (bf16)f2bf(bflo(k.z) * sk); d[360] = (bf16)f2bf(bfhi(k.z) * sk); d[432] = (bf16)f2bf(bflo(k.w) * sk); d[504] = (bf16)f2bf(bfhi(k.w) * sk); }
    if (tid == 0) *(LAS float*)(buf + B2_EGL) = __expf(R.glast);
}
__device__ __forceinline__ bf16x8_t ldA(const LAS unsigned char* p) {
    const s16x4_t lo = *(const LAS s16x4_t*)p, hi = *(const LAS s16x4_t*)(p + 32);
    return (bf16x8_t){lo[0], lo[1], lo[2], lo[3], hi[0], hi[1], hi[2], hi[3]};
}
__device__ __forceinline__ bf16x8_t packB(const f32x4& a, const f32x4& b) {
    u32x4 w; w.x = cvtpk(a[0], a[1]); w.y = cvtpk(a[2], a[3]); w.z = cvtpk(b[0], b[1]); w.w = cvtpk(b[2], b[3]);
    return __builtin_bit_cast(bf16x8_t, w);
}
#define B2_PIPE(N) do { __builtin_amdgcn_sched_group_barrier(0x100, 4, 0); _Pragma("unroll") for (int i_ = 0; i_ < (N) - 4; ++i_) { __builtin_amdgcn_sched_group_barrier(0x008, 1, 0); __builtin_amdgcn_sched_group_barrier(0x100, 1, 0); } \
    __builtin_amdgcn_sched_group_barrier(0x008, 4, 0); } while (0)

template <int O0, int O1, int O2, int O3, int O4, int O5, int O6, int O7>
__device__ __forceinline__ void rd8(s16x4_t (&d)[8], unsigned base) {
    asm volatile("ds_read_b64 %0, %8 offset:%9\n\tds_read_b64 %1, %8 offset:%10\n\tds_read_b64 %2, %8 offset:%11\n\tds_read_b64 %3, %8 offset:%12\n\t"
                 "ds_read_b64 %4, %8 offset:%13\n\tds_read_b64 %5, %8 offset:%14\n\tds_read_b64 %6, %8 offset:%15\n\tds_read_b64 %7, %8 offset:%16"
                 : "=&v"(d[0]), "=&v"(d[1]), "=&v"(d[2]), "=&v"(d[3]), "=&v"(d[4]), "=&v"(d[5]), "=&v"(d[6]), "=&v"(d[7])
                 : "v"(base), "n"(O0), "n"(O1), "n"(O2), "n"(O3), "n"(O4), "n"(O5), "n"(O6), "n"(O7) : "memory");
}
struct Frag8 { s16x4_t lo[8], hi[8]; };
template <int OFF, int STEP_T, int KS2> __device__ __forceinline__ void frag_issue(Frag8& f, unsigned base) {
    rd8<OFF, OFF + STEP_T, OFF + 2 * STEP_T, OFF + 3 * STEP_T, OFF + KS2, OFF + KS2 + STEP_T, OFF + KS2 + 2 * STEP_T, OFF + KS2 + 3 * STEP_T>(f.lo, base);
    rd8<OFF + 32, OFF + STEP_T + 32, OFF + 2 * STEP_T + 32, OFF + 3 * STEP_T + 32, OFF + KS2 + 32, OFF + KS2 + STEP_T + 32, OFF + KS2 + 2 * STEP_T + 32, OFF + KS2 + 3 * STEP_T + 32>(f.hi, base);
}
__device__ __forceinline__ void frag_wait(Frag8& f) {
    asm volatile("s_waitcnt lgkmcnt(0)" : "+v"(f.lo[0]), "+v"(f.lo[1]), "+v"(f.lo[2]), "+v"(f.lo[3]), "+v"(f.lo[4]), "+v"(f.lo[5]), "+v"(f.lo[6]), "+v"(f.lo[7]) :: "memory");
    asm volatile("s_waitcnt lgkmcnt(0)" : "+v"(f.hi[0]), "+v"(f.hi[1]), "+v"(f.hi[2]), "+v"(f.hi[3]), "+v"(f.hi[4]), "+v"(f.hi[5]), "+v"(f.hi[6]), "+v"(f.hi[7]) :: "memory");
}
__device__ __forceinline__ bf16x8_t frag_get(const Frag8& f, int i) { return (bf16x8_t){f.lo[i][0], f.lo[i][1], f.lo[i][2], f.lo[i][3], f.hi[i][0], f.hi[i][1], f.hi[i][2], f.hi[i][3]}; }
template <int OFF, int STRIDE, int T0, int KS> __device__ __forceinline__ void b2_rd4(bf16x8_t (&A)[8], int slot, const LAS unsigned char* const (&q)[4]) {
#pragma unroll
    for (int t = 0; t < 4; ++t) { const int o = OFF + (16 * (T0 + t)) * STRIDE + 64 * (KS & ~1);
        const s16x4_t lo = *(const LAS s16x4_t*)(q[2 * (KS & 1)] + o), hi = *(const LAS s16x4_t*)(q[2 * (KS & 1) + 1] + o);
        A[slot + t] = (bf16x8_t){lo[0], lo[1], lo[2], lo[3], hi[0], hi[1], hi[2], hi[3]}; }
}
__device__ __forceinline__ void b2_step(LAS unsigned char* buf, f32x4 (&S)[8], const u32x4 (&uq)[2], LAS unsigned char* scr, bf16* Orow, int lane, int g, int l15) {
    *(LAS u32x4*)(scr + lane * 32) = uq[0]; *(LAS u32x4*)(scr + lane * 32 + 16) = uq[1];
    LDS_WAIT();
    unsigned short ur[4][4];
#pragma unroll
    for (int t = 0; t < 4; ++t)
#pragma unroll
        for (int r = 0; r < 4; ++r) ur[t][r] = *(const LAS bf16*)(scr + (16 * t + 4 * g + r) * 32 + l15 * 2);
    const LAS unsigned char* b272[4]; const LAS unsigned char* b144[4];
#pragma unroll
    for (int i = 0; i < 4; ++i) { b272[i] = buf + l15 * 272 + g * 8 + 32 * i; b144[i] = buf + l15 * 144 + g * 8 + 32 * i; asm volatile("" : "+v"(b272[i]), "+v"(b144[i])); }
    bf16x8_t A0[8], A1[8];
    b2_rd4<B2_NW, 272, 0, 0>(A0, 0, b272); b2_rd4<B2_NW, 272, 0, 1>(A0, 4, b272);
    f32x4 vn[4];
#pragma unroll
    for (int t = 0; t < 4; ++t)
#pragma unroll
        for (int r = 0; r < 4; ++r) vn[t][r] = bf2f(ur[t][r]);
    bf16x8_t Sb[4];
#pragma unroll
    for (int ks = 0; ks < 4; ++ks) Sb[ks] = packB(S[2 * ks], S[2 * ks + 1]);
    __builtin_amdgcn_sched_barrier(0);
    b2_rd4<B2_NW, 272, 0, 2>(A1, 0, b272); b2_rd4<B2_NW, 272, 0, 3>(A1, 4, b272);
#pragma unroll
    for (int i = 0; i < 8; ++i) vn[i & 3] = __builtin_amdgcn_mfma_f32_16x16x32_bf16(A0[i], Sb[i >> 2], vn[i & 3], 0, 0, 0);
    __builtin_amdgcn_sched_barrier(0);
    b2_rd4<B2_QG, 272, 0, 0>(A0, 0, b272); b2_rd4<B2_QG, 272, 0, 1>(A0, 4, b272);
#pragma unroll
    for (int i = 0; i < 8; ++i) vn[i & 3] = __builtin_amdgcn_mfma_f32_16x16x32_bf16(A1[i], Sb[2 + (i >> 2)], vn[i & 3], 0, 0, 0);
    __builtin_amdgcn_sched_barrier(0);
    bf16x8_t vb[2];
#pragma unroll
    for (int ks = 0; ks < 2; ++ks) vb[ks] = packB(vn[2 * ks], vn[2 * ks + 1]);
    f32x4 o[4];
#pragma unroll
    for (int t = 0; t < 4; ++t) o[t] = (f32x4){0.f, 0.f, 0.f, 0.f};
    b2_rd4<B2_QG, 272, 0, 2>(A1, 0, b272); b2_rd4<B2_QG, 272, 0, 3>(A1, 4, b272);
#pragma unroll
    for (int i = 0; i < 8; ++i) o[i & 3] = __builtin_amdgcn_mfma_f32_16x16x32_bf16(A0[i], Sb[i >> 2], o[i & 3], 0, 0, 0);
    __builtin_amdgcn_sched_barrier(0);
    b2_rd4<B2_QK, 144, 0, 0>(A0, 0, b144); b2_rd4<B2_QK, 144, 0, 1>(A0, 4, b144);
#pragma unroll
    for (int i = 0; i < 8; ++i) o[i & 3] = __builtin_amdgcn_mfma_f32_16x16x32_bf16(A1[i], Sb[2 + (i >> 2)], o[i & 3], 0, 0, 0);
    __builtin_amdgcn_sched_barrier(0);
    b2_rd4<B2_KGT, 144, 0, 0>(A1, 0, b144); b2_rd4<B2_KGT, 144, 4, 0>(A1, 4, b144);
#pragma unroll
    for (int i = 0; i < 8; ++i) o[i & 3] = __builtin_amdgcn_mfma_f32_16x16x32_bf16(A0[i], vb[i >> 2], o[i & 3], 0, 0, 0);
    __builtin_amdgcn_sched_barrier(0);
#pragma unroll
    for (int t = 0; t < 4; ++t)
#pragma unroll
        for (int r = 0; r < 4; ++r) *(LAS bf16*)(scr + (16 * t + 4 * g + r) * 32 + l15 * 2) = (bf16)f2bf(o[t][r]);
    LDS_WAIT();
    { const u32x4 w0 = *(const LAS u32x4*)(scr + lane * 32), w1 = *(const LAS u32x4*)(scr + lane * 32 + 16); *(u32x4*)Orow = w0; *(u32x4*)(Orow + 8) = w1; }
    const float egl = *(const LAS float*)(buf + B2_EGL);
#pragma unroll
    for (int t = 0; t < 8; ++t) S[t] = S[t] * egl;
    b2_rd4<B2_KGT, 144, 0, 1>(A0, 0, b144); b2_rd4<B2_KGT, 144, 4, 1>(A0, 4, b144);
#pragma unroll
    for (int i = 0; i < 8; ++i) S[i] = __builtin_amdgcn_mfma_f32_16x16x32_bf16(A1[i], vb[0], S[i], 0, 0, 0);
    __builtin_amdgcn_sched_barrier(0);
#pragma unroll
    for (int i = 0; i < 8; ++i) S[i] = __builtin_amdgcn_mfma_f32_16x16x32_bf16(A0[i], vb[1], S[i], 0, 0, 0);
}
__device__ __forceinline__ void b2_uload(const bf16* Urow, u32x4 (&uq)[2]) { uq[0] = *(const u32x4*)Urow; uq[1] = *(const u32x4*)(Urow + 8); }
__device__ __forceinline__ void b2_chain(const Params& P, const Ctx& C, int chain) {
    const int b = chain >> 3, h = (chain >> 1) & 3, dir = chain & 1;
    int tid_ = C.tid; asm volatile("" : "+v"(tid_)); const int tid = tid_, lane = tid & 63, g = lane >> 4, l15 = lane & 15;
    LAS unsigned char* base = C.lds;
    const int v0 = 16 * C.wave;
    const bf16* Ug = (const bf16*)(P.ws + WS_U) + (size_t)chain * 8192 + lane * 128 + v0;
    bf16* OUT = (bf16*)(P.ws + (dir ? WS_OB : WS_OF)) + (size_t)b * SEQ * 512 + (dir ? 63 - lane : lane) * 512 + h * 128 + v0;
    LAS unsigned char* scr = base + 2 * B2_BUF + C.wave * 2048;
    B2Regs R0, R1;
    u32x4 u0[2], u1[2];
    f32x4 S[8];
#pragma unroll
    for (int t = 0; t < 8; ++t) S[t] = (f32x4){0.f, 0.f, 0.f, 0.f};
    b2_load(P, chain, 0, tid, R0); b2_uload(Ug, u0);
    b2_load(P, chain, 1, tid, R1); b2_uload(Ug + (size_t)64 * 8192, u1);
    b2_write(R0, base, tid);
    LDS_BARRIER();
    for (int n = 0; n < 32; n += 2) {
        if (n + 2 < 32) b2_load(P, chain, n + 2, tid, R0);
        { const int c = dir ? 31 - n : n; b2_step(base, S, u0, scr, OUT + (size_t)c * 64 * 512, lane, g, l15); }
        if (n + 2 < 32) b2_uload(Ug + (size_t)(n + 2) * 64 * 8192, u0);
        b2_write(R1, base + B2_BUF, tid);
        LDS_BARRIER();
        if (n + 3 < 32) b2_load(P, chain, n + 3, tid, R1);
        { const int c = dir ? 31 - (n + 1) : n + 1; b2_step(base + B2_BUF, S, u1, scr, OUT + (size_t)c * 64 * 512, lane, g, l15); }
        if (n + 3 < 32) b2_uload(Ug + (size_t)(n + 3) * 64 * 8192, u1);
        if (n + 2 < 32) b2_write(R0, base, tid);
        LDS_BARRIER();
    }
}

constexpr int AT_K = 0, AT_V = 9216, AT_BUF = 18432, AT_ITEM = 40960;
template <int MODE>
__device__ __forceinline__ void attn_item(const Params& P, const Ctx& C, int item) {
    constexpr bool IS_A = MODE == 1;
    int tid_ = C.tid; asm volatile("" : "+v"(tid_)); const int tid = tid_, lane = tid & 63, r = lane & 31, hh = lane >> 5; const int wave = C.wave;
    LAS unsigned char* L = C.lds;
    const bf16* PROJ = (const bf16*)(P.ws + WS_PROJ); bf16* MIX = (bf16*)(P.ws + WS_MIX);
    int b, tw, qcol, kcol, vcol, ocol, kt_lo, kt_hi, hA = 0, rres = 0; const bf16* VT;
    if (MODE == 1) { b = item >> 5; const int h = (item >> 3) & 3, q0 = (item & 7) * 256; hA = h; VT = (const bf16*)(P.ws + WS_VTA) + ((size_t)(b * 4 + h) * 64) * SEQ; tw = q0 + 32 * wave; qcol = PC_QA + 64 * h; kcol = PC_KA + 64 * h; vcol = PC_VA + 64 * h; ocol = 64 * h;
        kt_lo = q0 - 256 < 0 ? 0 : (q0 - 256) >> 6; kt_hi = ((q0 + 511) >> 6) + 1; if (kt_hi > 32) kt_hi = 32; }
    else if (MODE == 2) { b = item >> 6; const int h = (item >> 4) & 3; hA = h; rres = item & 15; VT = (const bf16*)(P.ws + WS_VT3) + ((size_t)((b * 4 + h) * 16 + rres) * 64) * 128; tw = 32 * (wave & 3); qcol = PC_QA + 64 * h; kcol = PC_KA + 64 * h; vcol = 0; ocol = 0;
        kt_lo = 0; kt_hi = 2; }
    else { b = item >> 5; const int kvh = (item >> 4) & 1, q0 = (item & 15) * 128, qh = kvh * 2 + (wave >> 2); VT = (const bf16*)(P.ws + WS_VTC) + ((size_t)(b * 2 + kvh) * 64) * SEQ; tw = q0 + 32 * (wave & 3); qcol = PC_QC + 64 * qh; kcol = PC_KC + 64 * kvh; vcol = PC_VC + 64 * kvh; ocol = 768 + 64 * qh;
        kt_lo = 0; kt_hi = 32; }
    const size_t tokb = (size_t)b * SEQ;
    const int q = tw + r;
    bf16x8_t qf[4];
    const size_t qtok = tokb + (MODE == 2 ? rres + 16 * q : q);
#pragma unroll
    for (int s4 = 0; s4 < 4; ++s4) qf[s4] = *(const bf16x8_t*)(PROJ + qtok * NPROJ + qcol + 16 * s4 + 8 * hh);
    unsigned mask16 = 0u, mask4 = 0u;
    if (IS_A) {
#pragma unroll
        for (int e = 0; e < 16; ++e) { const int kr = (e & 3) + 8 * (e >> 2) + 4 * hh; const int d = kr - q;
            if ((d & 15) == 0) mask16 |= (1u << e) | (1u << (16 + e)); if ((d & 3) == 0) mask4 |= (1u << e) | (1u << (16 + e)); }
    }
    const int kkey = tid >> 3, kp = tid & 7;
    constexpr size_t KSTEP = (MODE == 2 ? 16 : 1) * (size_t)64 * NPROJ;
    const bf16* ksrc = PROJ + (tokb + (MODE == 2 ? rres + 16 * kkey : kkey)) * NPROJ + kcol + 8 * kp; const bf16* vsrc = VT + (size_t)kkey * (MODE == 2 ? 128 : SEQ) + 8 * kp;
    const int kdst = AT_K + kkey * 144 + kp * 16, vdst = AT_V + kkey * 144 + kp * 16;
    u32x4 kreg = *(const u32x4*)(ksrc + (size_t)kt_lo * KSTEP), vreg = *(const u32x4*)(vsrc + kt_lo * 64);
#define AT_WRITE(bufo) do { *(LAS u32x4*)(L + (bufo) + kdst) = kreg; *(LAS u32x4*)(L + (bufo) + vdst) = vreg; } while (0)
    AT_WRITE(0);
    f32x16_t o0, o1;
#pragma unroll
    for (int e = 0; e < 16; ++e) { o0[e] = 0.f; o1[e] = 0.f; }
    float m = -INFINITY, l = 0.f;
    float* part = (float*)((unsigned char*)(P.ws + WS_PROJ) + qtok * (size_t)(NPROJ * 2) + PC_QB * 2) + hA * 68;
    if (MODE == 1) { m = part[64]; l = hh == 0 ? part[65] : 0.f;
#pragma unroll
        for (int g4 = 0; g4 < 4; ++g4) { const f32x4 a = *(const f32x4*)(part + 8 * g4 + 4 * hh), c4 = *(const f32x4*)(part + 32 + 8 * g4 + 4 * hh);
#pragma unroll
            for (int e = 0; e < 4; ++e) { o0[4 * g4 + e] = a[e]; o1[4 * g4 + e] = c4[e]; } } }
    __syncthreads();
    for (int kt = kt_lo; kt < kt_hi; ++kt) {
        const int cur = ((kt - kt_lo) & 1) * AT_BUF;
        if (kt + 1 < kt_hi) { kreg = *(const u32x4*)(ksrc + (size_t)(kt + 1) * KSTEP); vreg = *(const u32x4*)(vsrc + (kt + 1) * 64); }
        const int k0 = kt * 64;
        const int dlo = k0 - (tw + 31), dhi = k0 + 63 - tw;
        const int dmin = dlo > 0 ? dlo : (dhi < 0 ? -dhi : 0), dmax = -dlo > dhi ? -dlo : dhi;
        if ((MODE != 1 || dmin <= 256) && !(MODE == 2 && wave >= 4)) {
            f32x16_t s0, s1;
#pragma unroll
            for (int e = 0; e < 16; ++e) { s0[e] = 0.f; s1[e] = 0.f; }
            const LAS unsigned char* kb = L + cur + AT_K + r * 144 + hh * 16;
#pragma unroll
            for (int s4 = 0; s4 < 4; ++s4) { const bf16x8_t a0 = *(const LAS bf16x8_t*)(kb + s4 * 32), a1 = *(const LAS bf16x8_t*)(kb + 32 * 144 + s4 * 32);
                s0 = __builtin_amdgcn_mfma_f32_32x32x16_bf16(a0, qf[s4], s0, 0, 0, 0); s1 = __builtin_amdgcn_mfma_f32_32x32x16_bf16(a1, qf[s4], s1, 0, 0, 0); }
            float w0[16], w1[16];
            if (IS_A) {
#pragma unroll
                for (int e = 0; e < 16; ++e) { const int kr = (e & 3) + 8 * (e >> 2) + 4 * hh;
                    { const int d = k0 + kr - q, ad = d < 0 ? -d : d; w0[e] = (ad <= 64 ? 1.f : 0.f) + (((mask4 >> e) & 1u) && ad <= 256 ? 1.f : 0.f); }
                    { const int d = k0 + 32 + kr - q, ad = d < 0 ? -d : d; w1[e] = (ad <= 64 ? 1.f : 0.f) + (((mask4 >> e) & 1u) && ad <= 256 ? 1.f : 0.f); } }
#pragma unroll
                for (int e = 0; e < 16; ++e) { if (w0[e] == 0.f) s0[e] = -INFINITY; if (w1[e] == 0.f) s1[e] = -INFINITY; }
            }
            if (MODE == 2 && dmax > 64) {
#pragma unroll
                for (int e = 0; e < 16; ++e) { const int kr = (e & 3) + 8 * (e >> 2) + 4 * hh;
                    { const int d = k0 + kr - q, ad = d < 0 ? -d : d; if (ad > 64) s0[e] = -INFINITY; }
                    { const int d = k0 + 32 + kr - q, ad = d < 0 ? -d : d; if (ad > 64) s1[e] = -INFINITY; } }
            }
            float mx = fmaxf(s0[0], s1[0]);
#pragma unroll
            for (int e = 1; e < 16; ++e) mx = fmaxf(mx, fmaxf(s0[e], s1[e]));
            mx = fmaxf(mx, __shfl_xor(mx, 32));
            const float mn = fmaxf(m, mx), mu = mn == -INFINITY ? 0.f : mn;
            const float alpha = __builtin_amdgcn_exp2f(m - mu);
            float ps = 0.f;
#pragma unroll
            for (int e = 0; e < 16; ++e) { float p0 = __builtin_amdgcn_exp2f(s0[e] - mu), p1 = __builtin_amdgcn_exp2f(s1[e] - mu); if (IS_A) { p0 *= w0[e]; p1 *= w1[e]; } s0[e] = p0; s1[e] = p1; ps += p0 + p1; }
            l = l * alpha + ps; m = mn;
#pragma unroll
            for (int e = 0; e < 16; ++e) { o0[e] *= alpha; o1[e] *= alpha; }
            bf16x8_t pb[2][2];
#pragma unroll
            for (int s2 = 0; s2 < 2; ++s2) {
                u32x4 w; w.x = cvtpk(s0[8 * s2], s0[8 * s2 + 1]); w.y = cvtpk(s0[8 * s2 + 2], s0[8 * s2 + 3]); w.z = cvtpk(s0[8 * s2 + 4], s0[8 * s2 + 5]); w.w = cvtpk(s0[8 * s2 + 6], s0[8 * s2 + 7]); pb[0][s2] = __builtin_bit_cast(bf16x8_t, w);
                w.x = cvtpk(s1[8 * s2], s1[8 * s2 + 1]); w.y = cvtpk(s1[8 * s2 + 2], s1[8 * s2 + 3]); w.z = cvtpk(s1[8 * s2 + 4], s1[8 * s2 + 5]); w.w = cvtpk(s1[8 * s2 + 6], s1[8 * s2 + 7]); pb[1][s2] = __builtin_bit_cast(bf16x8_t, w); }
            const LAS unsigned char* vq[8];
#pragma unroll
            for (int i = 0; i < 8; ++i) { vq[i] = L + cur + AT_V + r * 144 + hh * 8 + 16 * i; asm volatile("" : "+v"(vq[i])); }
#pragma unroll
            for (int u = 0; u < 2; ++u)
#pragma unroll
                for (int s2 = 0; s2 < 2; ++s2) { const int ki = 2 * (2 * u + s2);
                    const s16x4_t lo0 = *(const LAS s16x4_t*)(vq[ki]), hi0 = *(const LAS s16x4_t*)(vq[ki + 1]), lo1 = *(const LAS s16x4_t*)(vq[ki] + 32 * 144), hi1 = *(const LAS s16x4_t*)(vq[ki + 1] + 32 * 144);
                    const bf16x8_t a0 = (bf16x8_t){lo0[0], lo0[1], lo0[2], lo0[3], hi0[0], hi0[1], hi0[2], hi0[3]}, a1 = (bf16x8_t){lo1[0], lo1[1], lo1[2], lo1[3], hi1[0], hi1[1], hi1[2], hi1[3]};
                    o0 = __builtin_amdgcn_mfma_f32_32x32x16_bf16(a0, pb[u][s2], o0, 0, 0, 0); o1 = __builtin_amdgcn_mfma_f32_32x32x16_bf16(a1, pb[u][s2], o1, 0, 0, 0); }
        }
        if (kt + 1 < kt_hi) AT_WRITE(cur ^ AT_BUF);
        __syncthreads();
    }
#undef AT_WRITE
    const float lt = l + __shfl_xor(l, 32);
    if (MODE == 2) {
        if (wave < 4) {
#pragma unroll
            for (int g4 = 0; g4 < 4; ++g4) { *(f32x4*)(part + 8 * g4 + 4 * hh) = (f32x4){o0[4 * g4], o0[4 * g4 + 1], o0[4 * g4 + 2], o0[4 * g4 + 3]};
                *(f32x4*)(part + 32 + 8 * g4 + 4 * hh) = (f32x4){o1[4 * g4], o1[4 * g4 + 1], o1[4 * g4 + 2], o1[4 * g4 + 3]}; }
            if (hh == 0) { part[64] = m; part[65] = lt; } }
        return; }
    const float inv = __builtin_amdgcn_rcpf(lt);
    bf16* op = MIX + (tokb + q) * 1024 + ocol + 4 * hh;
#pragma unroll
    for (int g4 = 0; g4 < 4; ++g4) { u32x2 w; w.x = cvtpk(o0[4 * g4] * inv, o0[4 * g4 + 1] * inv); w.y = cvtpk(o0[4 * g4 + 2] * inv, o0[4 * g4 + 3] * inv); *(u32x2*)(op + 8 * g4) = w;
        w.x = cvtpk(o1[4 * g4] * inv, o1[4 * g4 + 1] * inv); w.y = cvtpk(o1[4 * g4 + 2] * inv, o1[4 * g4 + 3] * inv); *(u32x2*)(op + 32 + 8 * g4) = w; }
}
__device__ __forceinline__ void phase_b1(const Params& P, const Ctx& C, int L) {
    for (int item = blockIdx.x; item < 1024; item += gridDim.x) b1_item(P, C, item);
    for (int it = blockIdx.x; it < 512; it += gridDim.x) attn_item<2>(P, C, it);
}
__device__ __forceinline__ void phase_mix(const Params& P, const Ctx& C, int L, int rep) {
    unsigned* ctr = (unsigned*)(P.ws + WS_CTL) + 64 * L + 16 * rep;
    for (int chain = blockIdx.x; chain < 64; chain += gridDim.x) b2_chain(P, C, chain);
#if SPLIT_MX
    cg::this_grid().sync();
#endif
    for (;;) {
        if (C.tid == 0) *(LAS unsigned*)(C.lds + AT_ITEM) = atomicAdd(ctr, 1u);
        __syncthreads();
        const unsigned it = __builtin_amdgcn_readfirstlane(*(const LAS unsigned*)(C.lds + AT_ITEM));
        __syncthreads();
        if (it >= 512u) break;
        if (it < 256u) attn_item<1>(P, C, (int)it);
        else attn_item<0>(P, C, (int)it - 256);
    }
}

__device__ __forceinline__ void phase_finish(const Params& P, const Ctx& C, int L) {
    const bf16* OF = (const bf16*)(P.ws + WS_OF); const bf16* OB = (const bf16*)(P.ws + WS_OB); const bf16* PROJ = (const bf16*)(P.ws + WS_PROJ); bf16* MIX = (bf16*)(P.ws + WS_MIX);
    const f32x2_t on = *(const f32x2_t*)(P.in[I_ONORM] + L * 128 + 2 * C.lane);
    constexpr int FB = 8;
    for (int it0 = C.gw; it0 < M * 4; it0 += FB * C.ngw) {
        unsigned a[FB], bb[FB], zu[FB];
#pragma unroll
        for (int j = 0; j < FB; ++j) { const int it = it0 + j * C.ngw < M * 4 ? it0 + j * C.ngw : it0; const size_t tok = it >> 2; const int h = it & 3;
            a[j] = *(const unsigned*)(OF + tok * 512 + h * 128 + 2 * C.lane); bb[j] = *(const unsigned*)(OB + tok * 512 + h * 128 + 2 * C.lane); zu[j] = *(const unsigned*)(PROJ + tok * NPROJ + PC_ZB + h * 128 + 2 * C.lane); }
        float o0[FB], o1[FB], ss[FB];
#pragma unroll
        for (int j = 0; j < FB; ++j) { o0[j] = bflo(a[j]) + bflo(bb[j]); o1[j] = bfhi(a[j]) + bfhi(bb[j]); ss[j] = o0[j] * o0[j] + o1[j] * o1[j]; }
#pragma unroll
        for (int j = 0; j < FB; ++j) ss[j] = wave_sum(ss[j]);
#pragma unroll
        for (int j = 0; j < FB; ++j) { const int it = it0 + j * C.ngw; if (it < M * 4) { const size_t tok = it >> 2; const int h = it & 3;
            const float rs = __builtin_amdgcn_rsqf(ss[j] * (1.0f / 128.0f) + EPS); const float z0 = bflo(zu[j]), z1 = bfhi(zu[j]);
            *(unsigned*)(MIX + tok * 1024 + 256 + h * 128 + 2 * C.lane) = pk2(o0[j] * rs * on.x * z0 * __builtin_amdgcn_rcpf(1.0f + __expf(-z0)), o1[j] * rs * on.y * z1 * __builtin_amdgcn_rcpf(1.0f + __expf(-z1))); } }
    }
}

#ifndef SIMPLE_A
#define SIMPLE_A 0
#endif
#ifndef SPLIT_MX
#define SPLIT_MX 0
#endif
#ifndef REP
#define REP 0
#endif
#ifndef SKIP
#define SKIP 0
#endif
#define XB_TMO      128
#define XB_XCNT(j)  (256  + 64 * (j))
#define XB_XSUB(j)  (1280 + 64 * (j))
#define XB_XGEN(j)  (2304 + 64 * (j))
#define XB_TOP      3328
#define XB_TOPGEN   3392
#define XCD_BAR_WORDS 3456
#define XB_SPIN_CAP (1u << 18)

__device__ __forceinline__ unsigned xb_ld(unsigned* p)              { return __hip_atomic_load(p, __ATOMIC_RELAXED, __HIP_MEMORY_SCOPE_AGENT); }
__device__ __forceinline__ unsigned xb_add(unsigned* p, unsigned v) { return __hip_atomic_fetch_add(p, v, __ATOMIC_RELAXED, __HIP_MEMORY_SCOPE_AGENT); }
__device__ __forceinline__ unsigned xb_xcc_id() { return (unsigned)__builtin_amdgcn_s_getreg((3 << 11) | 20) & 0xFu; }
#define XB_SPIN(cond, bar) do { unsigned _sp = 0; while (cond) { __builtin_amdgcn_s_sleep(1); \
    if ((++_sp & 255u) == 0u) { if (xb_ld(&(bar)[XB_TMO])) break; if (_sp > XB_SPIN_CAP) { atomicAdd(&(bar)[XB_TMO], 1u); break; } } } } while (0)

struct XcdBarrier {
    unsigned* bar; unsigned x;
    volatile LAS unsigned* st;
};

__device__ __forceinline__ XcdBarrier xcd_barrier_post(unsigned* bar, volatile LAS unsigned* st) {
    XcdBarrier b; b.bar = bar; b.x = xb_xcc_id(); b.st = st;
    if (threadIdx.x == 0) (void)xb_add(&bar[XB_XCNT(b.x)], 1u);
    return b;
}
__device__ __forceinline__ void xcd_barrier_complete(unsigned* bar, unsigned x, unsigned& nloc, unsigned& nx) {
    const unsigned G = gridDim.x * gridDim.y * gridDim.z;
    unsigned sum, cnt, mine, sp = 0u;
    for (;;) {
        sum = 0u; cnt = 0u; mine = 0u;
#pragma unroll
        for (unsigned j = 0; j < 16; ++j) { const unsigned c = xb_ld(&bar[XB_XCNT(j)]); sum += c; cnt += (c > 0u) ? 1u : 0u; mine = (j == x) ? c : mine; }
        if (sum == G) break;
        __builtin_amdgcn_s_sleep(1);
        if ((++sp & 255u) == 0u) { if (xb_ld(&bar[XB_TMO])) break; if (sp > XB_SPIN_CAP) { atomicAdd(&bar[XB_TMO], 1u); break; } }
    }
    nloc = mine > 0u ? mine : 1u; nx = cnt > 0u ? cnt : 1u;
}

__device__ __forceinline__ void xcd_barrier(const XcdBarrier& b) {
    asm volatile("s_waitcnt vmcnt(0)" ::: "memory");
    __syncthreads();
    if (threadIdx.x == 0) {
        unsigned* bar = b.bar;
        __builtin_amdgcn_s_waitcnt(0);
        unsigned nloc = b.st[0], nx = b.st[1];
        if (nloc == 0u) { xcd_barrier_complete(bar, b.x, nloc, nx); b.st[0] = nloc; b.st[1] = nx; }
        const unsigned old = xb_add(&bar[XB_XSUB(b.x)], 1u);
        const unsigned gen = old / nloc;
        if (old + 1u == (gen + 1u) * nloc) {
            __builtin_amdgcn_fence(__ATOMIC_RELEASE, "agent");
            asm volatile("s_waitcnt vmcnt(0)" ::: "memory");
            const unsigned og = xb_add(&bar[XB_TOP], 1u);
            const unsigned tg = og / nx;
            if (og + 1u == (tg + 1u) * nx) xb_add(&bar[XB_TOPGEN], 1u);
            else XB_SPIN(xb_ld(&bar[XB_TOPGEN]) == tg, bar);
            __builtin_amdgcn_fence(__ATOMIC_ACQUIRE, "agent");
            xb_add(&bar[XB_XGEN(b.x)], 1u);
            asm volatile("s_waitcnt vmcnt(0)" ::: "memory");
        } else {
            XB_SPIN(xb_ld(&bar[XB_XGEN(b.x)]) == gen, bar);
            __builtin_amdgcn_fence(__ATOMIC_ACQUIRE, "agent");
            asm volatile("s_waitcnt vmcnt(0)" ::: "memory");
        }
    }
    __syncthreads();
}

__global__ void __launch_bounds__(512, 2) mega_fwd(Params P) {
    extern __shared__ __attribute__((aligned(16))) unsigned char lds[];
    cg::grid_group grid = cg::this_grid();
    { volatile LAS unsigned* st0 = (volatile LAS unsigned*)((LAS unsigned char*)lds + 147392); if (threadIdx.x < 2) st0[threadIdx.x] = 0u; }
    __syncthreads();
    XcdBarrier xbar = xcd_barrier_post((unsigned*)(P.ws + WS_CTL + 8192), (volatile LAS unsigned*)((LAS unsigned char*)lds + 147392));
    for (int ph = P.ph_lo; ph < P.ph_hi; ++ph) {
        const int L = ph / NPH, p = ph % NPH;
        const int nrep = ((REP >> p) & 1) ? 2 : 1;
        for (int rep = 0; rep < nrep; ++rep) {
        if (rep) xcd_barrier(xbar);
        int tid_ = threadIdx.x; asm volatile("" : "+v"(tid_));
        Ctx C; C.tid = tid_; C.lane = C.tid & 63; C.wave = __builtin_amdgcn_readfirstlane(C.tid >> 6); C.gw = blockIdx.x * 8 + C.wave; C.ngw = gridDim.x * 8; C.lds = (LAS unsigned char*)lds;
        unsigned char* ws = P.ws;
        if (p == 0) { if (!(SKIP & 1)) phase_n1(P, C, L); }
        else if (p == 1) { pg8::Gemm g{(const pg8::bf16_t*)(ws + WS_XN), (const pg8::bf16_t*)(ws + WS_WIN), M, NPROJ, DM}; pg8::StaticOrder S; S.init(M, NPROJ, gridDim.x, blockIdx.x);
            pg8::EpiStoreBf16 E{(pg8::bf16_t*)(ws + WS_PROJ), NPROJ}; pg8::gemm_phase<pg8::EpiStoreBf16, pg8::StaticOrder, true, true>(C.lds, g, S, E); }
        else if (p == 2) { if (!(SKIP & 2)) phase_prep(P, C, L); }
        else if (p == 3) { if (!(SKIP & 16)) phase_b1(P, C, L); }
        else if (p == 4) { if (!(SKIP & 4)) phase_mix(P, C, L, rep); }
        else if (p == 5) { if (!(SKIP & 8)) phase_finish(P, C, L); }
        else if (p == 6) { pg8::Gemm g{(const pg8::bf16_t*)(ws + WS_MIX), (const pg8::bf16_t*)(ws + WS_WO), M, DM, DM}; pg8::StaticOrder S; S.init(M, DM, gridDim.x, blockIdx.x);
            pg8::EpiResid E{L == 0 ? P.in[I_X] : P.out, (float*)(ws + WS_X1), DM}; pg8::gemm_phase<pg8::EpiResid, pg8::StaticOrder, true, true>(C.lds, g, S, E); }
        else if (p == 7) norm_rows<false>(P, C, L, (const float*)(ws + WS_X1), P.in[I_NORM2] + L * DM);
        else if (p == 8) { pg8::Gemm g{(const pg8::bf16_t*)(ws + WS_XN), (const pg8::bf16_t*)(ws + WS_WGU), M, NGU, DM}; pg8::StaticOrder S; S.init(M, NGU, gridDim.x, blockIdx.x);
            pg8::EpiSwiglu E{(pg8::bf16_t*)(ws + WS_PROJ), DFF}; pg8::gemm_phase<pg8::EpiSwiglu, pg8::StaticOrder, true, true>(C.lds, g, S, E); }
        else { pg8::Gemm g{(const pg8::bf16_t*)(ws + WS_PROJ), (const pg8::bf16_t*)(ws + WS_WD), M, DM, DFF}; pg8::StaticOrder S; S.init(M, DM, gridDim.x, blockIdx.x);
            pg8::EpiResid E{(const float*)(ws + WS_X1), P.out, DM}; pg8::gemm_phase<pg8::EpiResid, pg8::StaticOrder, true, true>(C.lds, g, S, E); }
        }
        if (ph + 1 < P.ph_hi) { if (ph == P.ph_lo) grid.sync(); else xcd_barrier(xbar); }
    }
}

#ifndef ONE_LAUNCH
#define ONE_LAUNCH 1
#endif
extern "C" void kernel_launch(void* const* d_in, const int* in_sizes, int n_in, void* d_out, int out_size, void* d_ws, size_t ws_size, hipStream_t stream) {
    static int grid = 0;
    if (!grid) {
        if (n_in != 15 || ws_size < WS_END) { fprintf(stderr, "kernel_launch: unexpected n_in %d / ws_size %zu (need %zu)\n", n_in, ws_size, (size_t)WS_END); return; }
        int dev = 0, cus = 0, per_cu = 0;
        hipGetDevice(&dev); hipDeviceGetAttribute(&cus, hipDeviceAttributeMultiprocessorCount, dev);
        hipFuncSetAttribute((const void*)mega_fwd, hipFuncAttributeMaxDynamicSharedMemorySize, LDS_BYTES);
        hipOccupancyMaxActiveBlocksPerMultiprocessor(&per_cu, mega_fwd, 512, LDS_BYTES);
        if (per_cu < 1) { fprintf(stderr, "kernel_launch: occupancy query says %d blocks per CU\n", per_cu); per_cu = 1; }
        grid = cus * per_cu;
    }
    Params p{};
    for (int i = 0; i < 15; ++i) p.in[i] = (const float*)d_in[i];
    p.out = (float*)d_out; p.ws = (unsigned char*)d_ws;
    hipMemsetAsync((char*)d_ws + WS_CTL, 0, 32768, stream);
#if ONE_LAUNCH
    p.ph_lo = 0; p.ph_hi = DEPTH * NPH;
    void* args[] = {&p};
    hipError_t e = hipLaunchCooperativeKernel((const void*)mega_fwd, dim3(grid), dim3(512), args, LDS_BYTES, stream);
    if (e != hipSuccess) fprintf(stderr, "cooperative launch failed: %s (grid %d)\n", hipGetErrorString(e), grid);
#else
    for (int ph = 0; ph < DEPTH * NPH; ++ph) { p.ph_lo = ph; p.ph_hi = ph + 1; hipLaunchKernelGGL(mega_fwd, dim3(grid), dim3(512), LDS_BYTES, stream, p); }
#endif
}
```

```cpp
#include <hip/hip_runtime.h>
#include <hip/hip_cooperative_groups.h>
#include <cstdio>
#include <cstdint>
namespace cg = cooperative_groups;
namespace pg8 {
#define PG8_LAS __attribute__((address_space(3)))
typedef unsigned short bf16_t;
typedef short bf16x8 __attribute__((ext_vector_type(8)));
typedef float f32x4 __attribute__((ext_vector_type(4)));
typedef unsigned u32x4 __attribute__((ext_vector_type(4)));
constexpr int BM = 256, BK = 64, HALF = 128, HTB = HALF * BK * 2  , STAGE_BYTES = 8 * HTB, NXCD = 8, WGM = 8;

__host__ __device__ __forceinline__ int lds_byte(int r, int c) { const int st = (r >> 4) * 2 + (c >> 5), rr = r & 15, cc = c & 31, ob = rr * 64 + cc * 2; return st * 1024 + (ob ^ (((ob >> 9) & 1) << 5)); }
__host__ __device__ __forceinline__ void stage_rc(int b, int& R, int& C) { const int st = b / 1024, sb = b % 1024, swz = sb ^ (((sb >> 9) & 1) << 5); R = (st >> 1) * 16 + swz / 64; C = (st & 1) * 32 + (swz % 64) / 2; }
__host__ __device__ __forceinline__ int perm32(int rho) { const int n = rho >> 4, i = rho & 15; return 8 * (i >> 2) + 4 * n + (i & 3); }

struct Unit { int pm, pn; };
struct Gemm { const bf16_t* A; const bf16_t* Bt; int M, N, K; };

struct StaticOrder {
    int nM, nN, nwg, G, c;
    __host__ __device__ void init(int M, int N, int G_, int c_) { nM = M / BM; nN = N / BM; nwg = nM * nN; G = G_; c = c_; }
    __host__ __device__ bool next(int i, Unit& u) const {
        const long L = (long)i * G + c; if (L >= nwg) return false;
        int wgid = (int)L; { const int q = nwg / NXCD, r = nwg % NXCD, xcd = wgid % NXCD, off = wgid / NXCD; wgid = (xcd < r ? xcd * (q + 1) : r * (q + 1) + (xcd - r) * q) + off; }
        const int nig = WGM * nN, gid = wgid / nig, fm = gid * WGM, gsz = (nM - fm) < WGM ? (nM - fm) : WGM;
        u.pm = fm + ((wgid % nig) % gsz); u.pn = (wgid % nig) / gsz; return true;
    }
    __device__ __forceinline__ void a_ready(const Unit&) const {}
    __device__ __forceinline__ void done(const Unit&) const {}
};

__device__ __forceinline__ unsigned cvt_pk_bf16(float lo, float hi) { unsigned r; asm volatile("v_cvt_pk_bf16_f32 %0, %1, %2" : "=v"(r) : "v"(lo), "v"(hi)); return r; }
typedef float f32x2 __attribute__((ext_vector_type(2)));
__device__ __forceinline__ float silu_f(float x) { return x * __builtin_amdgcn_rcpf(1.0f + __expf(-x)); }
struct EpiStoreBf16 {
    static constexpr bool PERM = true, AFTER_DRAIN = false;
    bf16_t* O; int ldc;
    __device__ __forceinline__ void operator()(const f32x4 (&acc)[2][2][4][2], const Unit& u, int wr, int wc, int fr, int fq) const {
        const int row0 = u.pm * BM + wr * 64 + fr; const int col0 = u.pn * BM + wc * 32 + 8 * fq;
#pragma unroll
        for (int ai = 0; ai < 2; ++ai)
#pragma unroll
            for (int m = 0; m < 4; ++m) { bf16_t* rowp = O + (size_t)(row0 + ai * HALF + m * 16) * ldc + col0;
#pragma unroll
                for (int bj = 0; bj < 2; ++bj) { const f32x4 v0 = acc[ai][bj][m][0], v1 = acc[ai][bj][m][1];
                    u32x4 w; w.x = cvt_pk_bf16(v0[0], v0[1]); w.y = cvt_pk_bf16(v0[2], v0[3]); w.z = cvt_pk_bf16(v1[0], v1[1]); w.w = cvt_pk_bf16(v1[2], v1[3]);
                    *(u32x4*)(rowp + bj * HALF) = w; } }
    }
};
struct EpiSwiglu {
    static constexpr bool PERM = true, AFTER_DRAIN = false;
    bf16_t* O; int ldc;
    __device__ __forceinline__ void operator()(const f32x4 (&acc)[2][2][4][2], const Unit& u, int wr, int wc, int fr, int fq) const {
        const int row0 = u.pm * BM + wr * 64 + fr; const int col0 = u.pn * HALF + wc * 32 + 8 * fq;
#pragma unroll
        for (int ai = 0; ai < 2; ++ai)
#pragma unroll
            for (int m = 0; m < 4; ++m) { bf16_t* rowp = O + (size_t)(row0 + ai * HALF + m * 16) * ldc + col0;
                const f32x4 g0 = acc[ai][0][m][0], g1 = acc[ai][0][m][1], u0 = acc[ai][1][m][0], u1 = acc[ai][1][m][1];
                f32x4 a, b;
#pragma unroll
                for (int e = 0; e < 4; ++e) { a[e] = silu_f(g0[e]) * u0[e]; b[e] = silu_f(g1[e]) * u1[e]; }
                u32x4 w; w.x = cvt_pk_bf16(a[0], a[1]); w.y = cvt_pk_bf16(a[2], a[3]); w.z = cvt_pk_bf16(b[0], b[1]); w.w = cvt_pk_bf16(b[2], b[3]);
                *(u32x4*)rowp = w; }
    }
};
struct EpiResid {
    static constexpr bool PERM = false, AFTER_DRAIN = false;
    const float* res; float* out; int ldc;
    __device__ __forceinline__ void operator()(const f32x4 (&acc)[2][2][4][2], const Unit& u, int wr, int wc, int fr, int fq) const {
        const int row0 = u.pm * BM + wr * 64 + fr; const int col0 = u.pn * BM + wc * 32 + 4 * fq;
#pragma unroll
        for (int ai = 0; ai < 2; ++ai)
#pragma unroll
            for (int m = 0; m < 4; ++m) { const size_t off = (size_t)(row0 + ai * HALF + m * 16) * ldc + col0;
#pragma unroll
                for (int bj = 0; bj < 2; ++bj)
#pragma unroll
                    for (int n = 0; n < 2; ++n) { const f32x4 r = *(const f32x4*)(res + off + bj * HALF + n * 16); *(f32x4*)(out + off + bj * HALF + n * 16) = r + acc[ai][bj][m][n]; } }
    }
};
template <class Epi, class Sched, bool ALIGN_EPI = false, bool SP2 = false>
__device__ __forceinline__ void gemm_phase(PG8_LAS unsigned char* lds, const Gemm g, const Sched& S, const Epi& E) {
    int tid_ = threadIdx.x; asm volatile("" : "+v"(tid_)); const int tid = tid_, wid = __builtin_amdgcn_readfirstlane(tid >> 6), lane = tid & 63, wr = wid >> 2, wc = wid & 3, fr = lane & 15, fq = lane >> 4;
    const int K = g.K, nt = K / BK;
    unsigned voffA[2], voffB[2];
#pragma unroll
    for (int i = 0; i < 2; ++i) { int R, C; stage_rc(tid * 16 + i * 8192, R, C); const int Rb = Epi::PERM ? ((R & ~31) + perm32(R & 31)) : R;
        voffA[i] = (unsigned)(R * K + C) * 2u; voffB[i] = (unsigned)(Rb * K + C) * 2u; }
    const size_t kstep = (size_t)(BK * 2);
    const size_t hstep = (size_t)HALF * K * 2;
    const size_t tstep = 2 * hstep;
    const unsigned ldsw = (unsigned)wid * 1024u;
    const int aoff = lds_byte(wr * 64 + fr, fq * 8), boff = lds_byte(wc * 32 + fr, fq * 8);
#define PG8_SA(b, h) (((b) * 2 + (h)) * HTB)
#define PG8_SB(b, h) ((4 + (b) * 2 + (h)) * HTB)
#define PG8_STAGE(bufoff, gbase, voff) do { _Pragma("unroll") for (int _i = 0; _i < 2; ++_i) \
        __builtin_amdgcn_global_load_lds((const unsigned*)((const char*)(gbase) + (voff)[_i]), (PG8_LAS unsigned*)(lds + (bufoff) + ldsw + _i * 8192), 16, 0, 0); } while (0)
#define PG8_LDA(dst, b, h) do { _Pragma("unroll") for (int m = 0; m < 4; ++m) _Pragma("unroll") for (int k = 0; k < 2; ++k) dst[m][k] = *(const PG8_LAS bf16x8*)(lds + PG8_SA(b, h) + aoff + m * 2048 + k * 1024); } while (0)
#define PG8_LDB(dst, b, h) do { _Pragma("unroll") for (int n = 0; n < 2; ++n) _Pragma("unroll") for (int k = 0; k < 2; ++k) dst[n][k] = *(const PG8_LAS bf16x8*)(lds + PG8_SB(b, h) + boff + n * 2048 + k * 1024); } while (0)
#define PG8_MMA(ai, bj, At, Bt) do { __builtin_amdgcn_s_setprio(1); _Pragma("unroll") for (int m = 0; m < 4; ++m) _Pragma("unroll") for (int n = 0; n < 2; ++n) _Pragma("unroll") for (int k = 0; k < 2; ++k) \
        acc[ai][bj][m][n] = __builtin_amdgcn_mfma_f32_16x16x32_bf16(Bt[n][k], At[m][k], acc[ai][bj][m][n], 0, 0, 0); __builtin_amdgcn_s_setprio(0); } while (0)
#define PG8_WAIT_V(n) asm volatile("s_waitcnt vmcnt(" #n ")" ::: "memory")
#define PG8_WAIT_L(n) asm volatile("s_waitcnt lgkmcnt(" #n ")" ::: "memory")
#define PG8_BAR __builtin_amdgcn_s_barrier()
#define PG8_SCHED __builtin_amdgcn_sched_barrier(0)
    Unit cur, nxt; int ui = 0;
    if (!S.next(0, cur)) return;
    f32x4 acc[2][2][4][2];
#pragma unroll
    for (int a = 0; a < 2; ++a)
#pragma unroll
        for (int b = 0; b < 2; ++b)
#pragma unroll
            for (int m = 0; m < 4; ++m)
#pragma unroll
                for (int n = 0; n < 2; ++n) acc[a][b][m][n] = (f32x4){0.f, 0.f, 0.f, 0.f};
    bf16x8 At[4][2], B0[2][2], B1[2][2];
    const char* cA = (const char*)g.A + (size_t)cur.pm * tstep; const char* cB = (const char*)g.Bt + (size_t)cur.pn * tstep;
    S.a_ready(cur);
    if constexpr (SP2) {
        PG8_STAGE(PG8_SB(0, 0), cB, voffB); PG8_STAGE(PG8_SB(0, 1), cB + hstep, voffB); PG8_STAGE(PG8_SA(0, 0), cA, voffA); PG8_STAGE(PG8_SA(0, 1), cA + hstep, voffA);
        if (wr == 1) PG8_BAR;
        PG8_WAIT_V(2); PG8_BAR;
        PG8_STAGE(PG8_SB(1, 0), cB + kstep, voffB); PG8_STAGE(PG8_SA(1, 0), cA + kstep, voffA); PG8_STAGE(PG8_SB(1, 1), cB + hstep + kstep, voffB);
        PG8_WAIT_V(6); PG8_BAR;
    } else {
        PG8_STAGE(PG8_SB(0, 0), cB, voffB); PG8_STAGE(PG8_SA(0, 0), cA, voffA); PG8_STAGE(PG8_SB(0, 1), cB + hstep, voffB); PG8_STAGE(PG8_SA(0, 1), cA + hstep, voffA);
        if (wr == 1) PG8_BAR;
        PG8_WAIT_V(4); PG8_BAR;
        PG8_STAGE(PG8_SB(1, 0), cB + kstep, voffB); PG8_STAGE(PG8_SA(1, 0), cA + kstep, voffA); PG8_STAGE(PG8_SB(1, 1), cB + hstep + kstep, voffB);
        PG8_WAIT_V(6); PG8_BAR;
    }
    for (;;) {
        const bool has_next = S.next(ui + 1, nxt);
        const char* nA = has_next ? (const char*)g.A + (size_t)nxt.pm * tstep : cA; const char* nB = has_next ? (const char*)g.Bt + (size_t)nxt.pn * tstep : cB;
        for (int t = 0; t < nt; t += 2) {
            const bool last = (t == nt - 2);
            const char* a1 = cA + (size_t)(t + 1) * kstep;
            const char* a2 = last ? nA : cA + (size_t)(t + 2) * kstep; const char* b2 = last ? nB : cB + (size_t)(t + 2) * kstep;
            const char* a3 = a2 + kstep; const char* b3 = b2 + kstep;
            if (last && has_next) S.a_ready(nxt);
            if constexpr (SP2) {
            PG8_LDB(B0, 0, 0); PG8_LDB(B1, 0, 1); PG8_SCHED; PG8_LDA(At, 0, 0); PG8_STAGE(PG8_SA(1, 1), a1 + hstep, voffA);
            PG8_WAIT_V(8); PG8_WAIT_L(0); PG8_BAR; PG8_MMA(0, 0, At, B0); PG8_MMA(0, 1, At, B1); PG8_BAR; PG8_SCHED;
            PG8_LDA(At, 0, 1); PG8_STAGE(PG8_SB(0, 0), b2, voffB); PG8_STAGE(PG8_SB(0, 1), b2 + hstep, voffB); PG8_STAGE(PG8_SA(0, 0), a2, voffA);
            PG8_WAIT_V(8); PG8_WAIT_L(0); PG8_BAR; PG8_MMA(1, 0, At, B0); PG8_MMA(1, 1, At, B1); PG8_BAR; PG8_SCHED;
            PG8_LDB(B0, 1, 0); PG8_LDB(B1, 1, 1); PG8_SCHED; PG8_LDA(At, 1, 0); PG8_STAGE(PG8_SA(0, 1), a2 + hstep, voffA);
            PG8_WAIT_V(8); PG8_WAIT_L(0); PG8_BAR; PG8_MMA(0, 0, At, B0); PG8_MMA(0, 1, At, B1); PG8_BAR; PG8_SCHED;
            PG8_LDA(At, 1, 1); PG8_STAGE(PG8_SB(1, 0), b3, voffB); PG8_STAGE(PG8_SB(1, 1), b3 + hstep, voffB); PG8_STAGE(PG8_SA(1, 0), a3, voffA);
            PG8_WAIT_V(8); PG8_WAIT_L(0); PG8_BAR; PG8_MMA(1, 0, At, B0); PG8_MMA(1, 1, At, B1); PG8_BAR; PG8_SCHED;
            } else {
            PG8_LDB(B0, 0, 0); PG8_SCHED; PG8_LDA(At, 0, 0); PG8_STAGE(PG8_SA(1, 1), a1 + hstep, voffA);
            PG8_WAIT_L(8); PG8_BAR; PG8_WAIT_L(0); PG8_MMA(0, 0, At, B0); PG8_BAR; PG8_SCHED;
            PG8_LDB(B1, 0, 1); PG8_STAGE(PG8_SB(0, 0), b2, voffB);
            PG8_BAR; PG8_WAIT_L(0); PG8_MMA(0, 1, At, B1); PG8_BAR;
            PG8_LDA(At, 0, 1); PG8_STAGE(PG8_SA(0, 0), a2, voffA);
            PG8_BAR; PG8_WAIT_L(0); PG8_MMA(1, 0, At, B0); PG8_BAR; PG8_SCHED;
            PG8_STAGE(PG8_SB(0, 1), b2 + hstep, voffB);
            PG8_WAIT_V(6); PG8_BAR; PG8_MMA(1, 1, At, B1); PG8_BAR;
            PG8_LDB(B0, 1, 0); PG8_SCHED; PG8_LDA(At, 1, 0); PG8_STAGE(PG8_SA(0, 1), a2 + hstep, voffA);
            PG8_WAIT_L(8); PG8_BAR; PG8_WAIT_L(0); PG8_MMA(0, 0, At, B0); PG8_BAR; PG8_SCHED;
            PG8_LDB(B1, 1, 1); PG8_STAGE(PG8_SB(1, 0), b3, voffB);
            PG8_BAR; PG8_WAIT_L(0); PG8_MMA(0, 1, At, B1); PG8_BAR;
            PG8_LDA(At, 1, 1); PG8_STAGE(PG8_SA(1, 0), a3, voffA);
            PG8_BAR; PG8_WAIT_L(0); PG8_MMA(1, 0, At, B0); PG8_BAR; PG8_SCHED;
            PG8_STAGE(PG8_SB(1, 1), b3 + hstep, voffB);
            PG8_WAIT_V(6); PG8_BAR; PG8_MMA(1, 1, At, B1); PG8_BAR;
            }
        }
        if constexpr (ALIGN_EPI) { if (wr == 0) PG8_BAR; }
        if constexpr (!Epi::AFTER_DRAIN) { E(acc, cur, wr, wc, fr, fq); S.done(cur); }
        if (!has_next) break;
#pragma unroll
        for (int a = 0; a < 2; ++a)
#pragma unroll
            for (int b = 0; b < 2; ++b)
#pragma unroll
                for (int m = 0; m < 4; ++m)
#pragma unroll
                    for (int n = 0; n < 2; ++n) acc[a][b][m][n] = (f32x4){0.f, 0.f, 0.f, 0.f};
        cur = nxt; cA = nA; cB = nB; ++ui;
        if constexpr (ALIGN_EPI) { if (wr == 1) PG8_BAR; }
    }
    PG8_WAIT_V(0);
    if constexpr (!ALIGN_EPI) { if (wr == 0) PG8_BAR; }
    PG8_BAR;
    if constexpr (Epi::AFTER_DRAIN) { E.fused(acc, cur, wr, wc, fr, fq, lds, wid, lane); S.done(cur); }
#undef PG8_SA
#undef PG8_SB
#undef PG8_STAGE
#undef PG8_LDA
#undef PG8_LDB
#undef PG8_MMA
#undef PG8_WAIT_V
#undef PG8_WAIT_L
#undef PG8_BAR
#undef PG8_SCHED
}
}
typedef float f32x2_t __attribute__((ext_vector_type(2)));
#define LAS __attribute__((address_space(3)))
typedef unsigned short bf16;
typedef float f32x4 __attribute__((ext_vector_type(4)));
typedef unsigned u32x4 __attribute__((ext_vector_type(4)));
typedef unsigned u32x2 __attribute__((ext_vector_type(2)));

constexpr int BATCH = 8, SEQ = 2048, DM = 1024, DEPTH = 4, M = BATCH * SEQ;
constexpr int INDIM = 3344, NPROJ = 3328, DFF = 2816, NGU = 2 * DFF, NBQKV = 1536;
constexpr int PC_QA = 0, PC_KA = 256, PC_VA = 512, PC_QB = 768, PC_KB = 1280, PC_VB = 1792, PC_ZB = 2304, PC_QC = 2816, PC_KC = 3072, PC_VC = 3200;
constexpr float EPS = 1e-6f;
constexpr int NPH = 10;
constexpr int LDS_BYTES = 147456;

constexpr size_t WS_CTL = 0;
constexpr size_t WS_G = 65536;
constexpr size_t WS_BETA = WS_G + (size_t)M * 8 * 4;
constexpr size_t WS_WIN = WS_BETA + (size_t)M * 8 * 4;
constexpr size_t WS_WO = WS_WIN + (size_t)NPROJ * DM * 2;
constexpr size_t WS_WGU = WS_WO + (size_t)DM * DM * 2;
constexpr size_t WS_WD = WS_WGU + (size_t)NGU * DM * 2;
constexpr size_t WS_XN = WS_WD + (size_t)DM * DFF * 2;
constexpr size_t WS_PROJ = WS_XN + (size_t)M * DM * 2;
constexpr size_t WS_X1 = WS_PROJ + (size_t)M * NPROJ * 2;
constexpr size_t WS_NW = WS_X1;
constexpr size_t WS_QB = WS_X1 + (size_t)M * 512 * 4;
constexpr size_t WS_KB = WS_QB + (size_t)M * 512 * 2;
constexpr size_t WS_U = WS_XN;
constexpr size_t WS_VB = WS_X1 + (size_t)M * DM * 4;
constexpr size_t WS_MIX = WS_VB + (size_t)M * 512 * 2;
constexpr size_t WS_QKD = WS_MIX + (size_t)M * DM * 2;
constexpr size_t WS_GCL = WS_QKD + (size_t)2048 * 4096 * 2;
constexpr size_t WS_OF = WS_GCL + (size_t)2048 * 64 * 4;
constexpr size_t WS_OB = WS_OF + (size_t)M * 512 * 2;
constexpr size_t WS_VTA = WS_OB + (size_t)M * 512 * 2;
constexpr size_t WS_VTC = WS_VTA + (size_t)M * 256 * 2;
constexpr size_t WS_VT3 = WS_VTC + (size_t)M * 128 * 2;
constexpr size_t WS_END = WS_VT3 + (size_t)M * 256 * 2;

struct Params { const float* in[15]; float* out; unsigned char* ws; int ph_lo, ph_hi; };
enum { I_X = 0, I_NORM1, I_WIN, I_QNA, I_KNA, I_CONV, I_ALOG, I_DTB, I_ONORM, I_QNC, I_KNC, I_WOUT, I_NORM2, I_WGU, I_WD };

__device__ __forceinline__ float bf2f(unsigned v) { return __uint_as_float(v << 16); }
__device__ __forceinline__ float bflo(unsigned v) { return __uint_as_float(v << 16); }
__device__ __forceinline__ float bfhi(unsigned v) { return __uint_as_float(v & 0xffff0000u); }
__device__ __forceinline__ unsigned pk2(float lo, float hi) { unsigned r; asm("v_cvt_pk_bf16_f32 %0, %1, %2" : "=v"(r) : "v"(lo), "v"(hi)); return r; }
__device__ __forceinline__ unsigned f2bf(float f) { return pk2(f, f) & 0xffffu; }
template <int CTRL> __device__ __forceinline__ float dpp_add(float v) { return v + __int_as_float(__builtin_amdgcn_update_dpp(0, __float_as_int(v), CTRL, 0xf, 0xf, true)); }
__device__ __forceinline__ float wave_sum(float v) {
    v = dpp_add<0xB1>(v); v = dpp_add<0x4E>(v); v = dpp_add<0x141>(v); v = dpp_add<0x140>(v);
    { const auto r16 = __builtin_amdgcn_permlane16_swap(__float_as_uint(v), __float_as_uint(v), false, false); v = __uint_as_float(r16[0]) + __uint_as_float(r16[1]); }
    { const auto r32 = __builtin_amdgcn_permlane32_swap(__float_as_uint(v), __float_as_uint(v), false, false); v = __uint_as_float(r32[0]) + __uint_as_float(r32[1]); }
    return v;
}
#define LDS_WAIT() asm volatile("s_waitcnt lgkmcnt(0)" ::: "memory")

struct Ctx { int tid, lane, wave, gw, ngw; LAS unsigned char* lds; };

__device__ __forceinline__ void tr_item(const float* __restrict__ W, int ldw, int K, int src_col0, bf16* WT, int dst_row0, int kb, LAS float* scr, int lane) {
    const int k0 = 64 * kb;
#pragma unroll 8
    for (int i = 0; i < 32; ++i) { const int kk = 2 * i + (lane >> 5); scr[kk * 33 + (lane & 31)] = W[(size_t)(k0 + kk) * ldw + src_col0 + (lane & 31)]; }
    LDS_WAIT();
    const int c = lane & 7;
#pragma unroll
    for (int j = 0; j < 4; ++j) { const int n = (lane >> 3) + 8 * j; const LAS float* s = scr + (8 * c) * 33 + n;
        u32x4 o; o.x = pk2(s[0 * 33], s[1 * 33]); o.y = pk2(s[2 * 33], s[3 * 33]); o.z = pk2(s[4 * 33], s[5 * 33]); o.w = pk2(s[6 * 33], s[7 * 33]);
        *(u32x4*)(WT + (size_t)(dst_row0 + n) * K + k0 + 8 * c) = o; }
    LDS_WAIT();
}

__device__ __forceinline__ void convert_weights(const Params& P, const Ctx& C, int L) {
    LAS float* scr = (LAS float*)(C.lds + C.wave * 16384);
    unsigned char* ws = P.ws;
    const float* win = P.in[I_WIN] + (size_t)L * DM * INDIM;
    const float* wout = P.in[I_WOUT] + (size_t)L * DM * DM;
    const float* wgu = P.in[I_WGU] + (size_t)L * DM * NGU;
    const float* wd = P.in[I_WD] + (size_t)L * DFF * DM;
    constexpr int N_IN = 16 * (NPROJ / 32), N_OUT = 16 * (DM / 32), N_GU = 16 * (NGU / 32), N_D = (DFF / 64) * (DM / 32);
    for (int it = C.gw; it < N_IN + N_OUT + N_GU + N_D; it += C.ngw) {
        int r = it;
        if (r < N_IN) { const int kb = r / (NPROJ / 32), nb = r % (NPROJ / 32), d0 = 32 * nb; tr_item(win, INDIM, DM, d0 < 2816 ? d0 : d0 + 16, (bf16*)(ws + WS_WIN), d0, kb, scr, C.lane); continue; }
        r -= N_IN;
        if (r < N_OUT) { const int kb = r / 32, nb = r % 32; tr_item(wout, DM, DM, 32 * nb, (bf16*)(ws + WS_WO), 32 * nb, kb, scr, C.lane); continue; }
        r -= N_OUT;
        if (r < N_GU) { const int kb = r / (NGU / 32), sb = r % (NGU / 32), j0 = 32 * sb; const int isup = j0 >= DFF, j = isup ? j0 - DFF : j0;
            tr_item(wgu, NGU, DM, j0, (bf16*)(ws + WS_WGU), (j / 128) * 256 + isup * 128 + (j % 128), kb, scr, C.lane); continue; }
        r -= N_GU;
        { const int kb = r / 32, nb = r % 32; tr_item(wd, DM, DFF, 32 * nb, (bf16*)(ws + WS_WD), 32 * nb, kb, scr, C.lane); }
    }
}

template <bool WITH_AB>
__device__ __forceinline__ void norm_rows(const Params& P, const Ctx& C, int L, const float* x, const float* nw) {
    bf16* XN = (bf16*)(P.ws + WS_XN);
    const LAS float* wab = (const LAS float*)C.lds;
    constexpr int RB = 4;
    for (int m0 = C.gw; m0 < M; m0 += RB * C.ngw) {
        f32x4 v[RB][4]; float rs[RB];
#pragma unroll
        for (int j = 0; j < RB; ++j) { const int m = m0 + j * C.ngw < M ? m0 + j * C.ngw : m0; const f32x4* xr = (const f32x4*)(x + (size_t)m * DM) + C.lane;
#pragma unroll
            for (int q = 0; q < 4; ++q) v[j][q] = xr[64 * q]; }
#pragma unroll
        for (int j = 0; j < RB; ++j) { float s = 0.f;
#pragma unroll
            for (int q = 0; q < 4; ++q) s += (v[j][q].x * v[j][q].x + v[j][q].y * v[j][q].y) + (v[j][q].z * v[j][q].z + v[j][q].w * v[j][q].w);
            rs[j] = s; }
#pragma unroll
        for (int j = 0; j < RB; ++j) rs[j] = __builtin_amdgcn_rsqf(wave_sum(rs[j]) * (1.0f / DM) + EPS);
#pragma unroll
        for (int q = 0; q < 4; ++q) { const f32x4 w4 = ((const f32x4*)nw)[C.lane + 64 * q];
#pragma unroll
            for (int j = 0; j < RB; ++j) v[j][q] = v[j][q] * rs[j] * w4; }
#pragma unroll
        for (int j = 0; j < RB; ++j) { const int m = m0 + j * C.ngw; if (m < M) { u32x2* o8 = (u32x2*)(XN + (size_t)m * DM) + C.lane;
#pragma unroll
            for (int q = 0; q < 4; ++q) { u32x2 o; o.x = pk2(v[j][q].x, v[j][q].y); o.y = pk2(v[j][q].z, v[j][q].w); o8[64 * q] = o; } } }
        if constexpr (WITH_AB) {
            float mine[RB];
#pragma unroll
            for (int j = 0; j < RB; ++j) mine[j] = 0.f;
#pragma unroll 2
            for (int c = 0; c < 16; ++c) {
                f32x2_t a2[RB];
#pragma unroll
                for (int j = 0; j < RB; ++j) a2[j] = (f32x2_t){0.f, 0.f};
#pragma unroll
                for (int q = 0; q < 4; ++q) { const f32x4 w4 = *(const LAS f32x4*)(wab + c * 1024 + 4 * C.lane + 256 * q);
#pragma unroll
                    for (int j = 0; j < RB; ++j) { a2[j] += (f32x2_t){v[j][q].x, v[j][q].y} * (f32x2_t){w4.x, w4.y}; a2[j] += (f32x2_t){v[j][q].z, v[j][q].w} * (f32x2_t){w4.z, w4.w}; } }
#pragma unroll
                for (int j = 0; j < RB; ++j) { const float a = wave_sum(a2[j].x + a2[j].y); if (C.lane == c) mine[j] = a; }
            }
#pragma unroll
            for (int j = 0; j < RB; ++j) { const int m = m0 + j * C.ngw; if (m < M) {
                if (C.lane < 8) {
                    const float al = P.in[I_ALOG][L * 8 + C.lane], dtb = P.in[I_DTB][L * 8 + C.lane];
                    const float xx = mine[j] + dtb; const float sp = xx > 20.f ? xx : log1pf(expf(xx));
                    ((float*)(P.ws + WS_G))[(size_t)m * 8 + C.lane] = -expf(al) * sp;
                } else if (C.lane < 16) {
                    ((float*)(P.ws + WS_BETA))[(size_t)m * 8 + C.lane - 8] = 1.0f / (1.0f + expf(-mine[j]));
                } } }
        }
    }
}

__device__ __forceinline__ void phase_n1(const Params& P, const Ctx& C, int L) {
    convert_weights(P, C, L);
    __syncthreads();
    {
        const float* win = P.in[I_WIN] + (size_t)L * DM * INDIM + 2816;
        LAS float* wab = (LAS float*)C.lds;
        for (int e = C.tid; e < 16 * 1024; e += 512) { const int k = e >> 4, c = e & 15; wab[c * 1024 + k] = win[(size_t)k * INDIM + c]; }
    }
    __syncthreads();
    const float* x = L == 0 ? P.in[I_X] : P.out;
    norm_rows<true>(P, C, L, x, P.in[I_NORM1] + L * DM);
    __syncthreads();
}

__device__ __forceinline__ void phase_prep(const Params& P, const Ctx& C, int L) {
    bf16* PROJ = (bf16*)(P.ws + WS_PROJ);
    bf16* QB = (bf16*)(P.ws + WS_QB); bf16* KB = (bf16*)(P.ws + WS_KB); bf16* VB = (bf16*)(P.ws + WS_VB);
    const int lane = C.lane;
    const float qna = P.in[I_QNA][L * 64 + lane], kna = P.in[I_KNA][L * 64 + lane], qnc = P.in[I_QNC][L * 64 + lane], knc = P.in[I_KNC][L * 64 + lane];
    const float invA = exp2f(-(float)(lane & 7) * (1.0f / 8.0f) * 18.931568569324174f);
    const float invC = exp2f(-(float)(lane & 15) * (1.0f / 16.0f) * 13.287712379549449f);
    const float* cw = P.in[I_CONV] + (size_t)L * 5 * NBQKV;
    for (int tb = C.gw; tb < M / 8; tb += C.ngw) {
      const int tokb = tb * 8, tbt = tokb & (SEQ - 1);
#pragma unroll 1
      for (int jb = 0; jb < 8; jb += 4) {
        unsigned xa4[4][8], xc4[4][6];
#pragma unroll
        for (int jj = 0; jj < 4; ++jj) { const bf16* prl = PROJ + (size_t)(tokb + jb + jj) * NPROJ;
#pragma unroll
            for (int v = 0; v < 8; ++v) xa4[jj][v] = prl[(v < 4 ? PC_QA : PC_KA) + (v & 3) * 64 + lane];
#pragma unroll
            for (int v = 0; v < 6; ++v) xc4[jj][v] = prl[(v < 4 ? PC_QC + v * 64 : PC_KC + (v - 4) * 64) + lane]; }
#pragma unroll
       for (int jj = 0; jj < 4; ++jj) {
        const int j = jb + jj;
        const int tok = tokb + j, t = tbt + j;
        bf16* pr = PROJ + (size_t)tok * NPROJ;
        unsigned xa[8], xc[6];
#pragma unroll
        for (int v = 0; v < 8; ++v) xa[v] = xa4[jj][v];
#pragma unroll
        for (int v = 0; v < 6; ++v) xc[v] = xc4[jj][v];
        float sA, cA;
        { float rev = (float)t * invA * 0.15915494309189535f; rev -= floorf(rev); sA = __builtin_amdgcn_sinf(rev); cA = __builtin_amdgcn_cosf(rev); }
        float ssa[8];
#pragma unroll
        for (int v = 0; v < 8; ++v) { const float x = bf2f(xa[v]); ssa[v] = wave_sum(x * x); }
#pragma unroll
        for (int v = 0; v < 8; ++v) {
            float y = bf2f(xa[v]) * (__builtin_amdgcn_rsqf(ssa[v] * (1.0f / 64.0f) + EPS)) * (v < 4 ? qna : kna);
            const float pa = __int_as_float(__builtin_amdgcn_update_dpp(0, __float_as_int(y), 0x128, 0xf, 0xf, true));
            if (lane < 8) y = y * cA - pa * sA; else if (lane < 16) y = y * cA + pa * sA;
            if (v < 4) y *= 0.18033688011112042f;
            pr[(v < 4 ? PC_QA : PC_KA) + (v & 3) * 64 + lane] = (bf16)f2bf(y);
        }
        float sC, cC;
        { const float pos = lane < 32 ? (float)(t >> 6) : (float)(t & 63); float rev = pos * invC * 0.15915494309189535f; rev -= floorf(rev); sC = __builtin_amdgcn_sinf(rev); cC = __builtin_amdgcn_cosf(rev); }
        float ssc[6];
#pragma unroll
        for (int v = 0; v < 6; ++v) { const float x = bf2f(xc[v]); ssc[v] = wave_sum(x * x); }
#pragma unroll
        for (int v = 0; v < 6; ++v) {
            float y = bf2f(xc[v]) * (__builtin_amdgcn_rsqf(ssc[v] * (1.0f / 64.0f) + EPS)) * (v < 4 ? qnc : knc);
            const float pa = __shfl_xor(y, 16);
            if ((lane & 16) == 0) y = y * cC - pa * sC; else y = y * cC + pa * sC;
            if (v < 4) y *= 0.18033688011112042f;
            pr[(v < 4 ? PC_QC + v * 64 : PC_KC + (v - 4) * 64) + lane] = (bf16)f2bf(y);
        }
       }
      }
#pragma unroll 1
      for (int part = 0; part < 3; ++part) {
        const bf16* src = PROJ + PC_QB + part * 512 + 2 * lane;
        f32x2_t w2[4][5]; unsigned rows[12][4];
#pragma unroll
        for (int h = 0; h < 4; ++h)
#pragma unroll
            for (int d = 0; d < 5; ++d) w2[h][d] = *(const f32x2_t*)(cw + d * NBQKV + part * 512 + h * 128 + 2 * lane);
#pragma unroll
        for (int rr = 0; rr < 12; ++rr) { const int tt = tbt + rr - 2;
#pragma unroll
            for (int h = 0; h < 4; ++h) rows[rr][h] = (tt >= 0 && tt < SEQ) ? *(const unsigned*)(src + (size_t)(tokb + rr - 2) * NPROJ + h * 128) : 0u; }
        bf16* dst = (part == 0 ? QB : (part == 1 ? KB : VB)) + 2 * lane;
#pragma unroll
        for (int j = 0; j < 8; ++j) {
            float a0[4], a1[4], ss[4];
#pragma unroll
            for (int h = 0; h < 4; ++h) { f32x2_t xx = (f32x2_t){0.f, 0.f};
#pragma unroll
                for (int d = 0; d < 5; ++d) xx += w2[h][d] * (f32x2_t){bflo(rows[j + d][h]), bfhi(rows[j + d][h])};
                const float x0 = xx.x, x1 = xx.y;
                a0[h] = x0 * __builtin_amdgcn_rcpf(1.0f + __expf(-x0)); a1[h] = x1 * __builtin_amdgcn_rcpf(1.0f + __expf(-x1)); ss[h] = a0[h] * a0[h] + a1[h] * a1[h]; }
            if (part < 2) {
#pragma unroll
                for (int h = 0; h < 4; ++h) ss[h] = wave_sum(ss[h]);
#pragma unroll
                for (int h = 0; h < 4; ++h) { float sc = __builtin_amdgcn_rsqf(ss[h] + EPS); if (part == 0) sc *= 0.08838834764831845f; a0[h] *= sc; a1[h] *= sc; } }
#pragma unroll
            for (int h = 0; h < 4; ++h) *(unsigned*)(dst + (size_t)(tokb + j) * 512 + h * 128) = pk2(a0[h], a1[h]);
        }
      }
    }
    {   LAS bf16* scr = (LAS bf16*)(C.lds + C.wave * 16384);
        for (int it = C.gw; it < BATCH * 6 * 32 + BATCH * 4 * 16 * 2; it += C.ngw) {
            const bf16* src; bf16* dst; size_t rstep = NPROJ, dstep = SEQ;
            if (it < BATCH * 6 * 32) { const int b = it / 192, hs = (it / 32) % 6, tb = it & 31;
                src = PROJ + ((size_t)b * SEQ + tb * 64) * NPROJ + (hs < 4 ? PC_VA + 64 * hs : PC_VC + 64 * (hs - 4)) + lane;
                dst = (hs < 4 ? (bf16*)(P.ws + WS_VTA) + ((size_t)(b * 4 + hs) * 64) * SEQ : (bf16*)(P.ws + WS_VTC) + ((size_t)(b * 2 + hs - 4) * 64) * SEQ) + tb * 64 + lane;
            } else { const int idx = it - BATCH * 6 * 32, b = idx >> 7, h = (idx >> 5) & 3, rr = (idx >> 1) & 15, half = idx & 1;
                src = PROJ + ((size_t)b * SEQ + rr + 16 * 64 * half) * NPROJ + PC_VA + 64 * h + lane; rstep = (size_t)16 * NPROJ;
                dst = (bf16*)(P.ws + WS_VT3) + ((size_t)((b * 4 + h) * 16 + rr) * 64) * 128 + half * 64 + lane; dstep = 128; }
#pragma unroll 8
            for (int i = 0; i < 64; ++i) scr[i * 66 + lane] = src[(size_t)i * rstep];
            LDS_WAIT();
#pragma unroll 8
            for (int d = 0; d < 64; ++d) dst[(size_t)d * dstep] = scr[lane * 66 + d];
            LDS_WAIT(); }
    }
}

#define LDS_BARRIER() do { asm volatile("s_waitcnt lgkmcnt(0)" ::: "memory"); __builtin_amdgcn_s_barrier(); asm volatile("" ::: "memory"); } while (0)
typedef short bf16x8_t __attribute__((ext_vector_type(8)));
typedef float f32x16_t __attribute__((ext_vector_type(16)));
typedef short s16x4_t __attribute__((ext_vector_type(4)));
__device__ __forceinline__ unsigned cvtpk(float lo, float hi) { unsigned r; asm volatile("v_cvt_pk_bf16_f32 %0, %1, %2" : "=v"(r) : "v"(lo), "v"(hi)); return r; }
template <int R0, int NR> __device__ __forceinline__ void b1_rows(f32x2_t (&sol)[32], const LAS float* Ar) {
#pragma unroll
    for (int ip = (R0 < 1 ? 1 : R0); ip < R0 + NR; ++ip) { f32x2_t a01 = (f32x2_t){0.f, 0.f}, a23 = (f32x2_t){0.f, 0.f};
#pragma unroll
        for (int j4 = 0; j4 < (ip + 3) / 4; ++j4) { const f32x4 a4 = *(const LAS f32x4*)(Ar + ip * 64 + 4 * j4);
            a01 -= (f32x2_t){a4.x, a4.y} * sol[2 * j4]; a23 -= (f32x2_t){a4.z, a4.w} * sol[2 * j4 + 1]; }
        const f32x2_t a = a01 + a23;
        sol[ip >> 1][ip & 1] += a.x + a.y; }
}
__device__ __forceinline__ void b1_item(const Params& P, const Ctx& C, int item) {
    const int b = item >> 7, c = (item >> 2) & 31, h = item & 3;
    int tid_ = C.tid; asm volatile("" : "+v"(tid_)); const int tid = tid_, lane = tid_ & 63;
    LAS unsigned char* L = C.lds;
    LAS unsigned char* Ks = L; LAS unsigned char* Qs = L + 17408;
    LAS float* KKf = (LAS float*)(L + 34816); LAS float* QKf = (LAS float*)(L + 51456);
    LAS float* gcl = (LAS float*)(L + 68096); LAS float* bel = gcl + 128;
    LAS float* Ad = (LAS float*)(L + 69120);
    const bf16* QB = (const bf16*)(P.ws + WS_QB); const bf16* KB = (const bf16*)(P.ws + WS_KB); const bf16* VB = (const bf16*)(P.ws + WS_VB);
    const float* G = (const float*)(P.ws + WS_G); const float* BETA = (const float*)(P.ws + WS_BETA);
    const size_t tok0 = (size_t)b * SEQ + c * 64;
#pragma unroll
    for (int m = 0; m < 2; ++m) { const int e = tid + 512 * m, r = e >> 4, p = e & 15;
        *(LAS u32x4*)(Ks + r * 272 + p * 16) = *(const u32x4*)(KB + (tok0 + r) * 512 + h * 128 + p * 8);
        *(LAS u32x4*)(Qs + r * 272 + p * 16) = *(const u32x4*)(QB + (tok0 + r) * 512 + h * 128 + p * 8); }
    u32x4 vpre[2];
#pragma unroll
    for (int m = 0; m < 2; ++m) { const int e = tid + 512 * m, r = e >> 4, p = e & 15; vpre[m] = *(const u32x4*)(VB + (tok0 + r) * 512 + h * 128 + p * 8); }
    if (tid < 128) { const int dir = tid >> 6, i = dir ? 63 - lane : lane; const size_t tok = tok0 + i;
        float g = G[tok * 8 + dir * 4 + h];
#pragma unroll
        for (int o = 1; o < 64; o <<= 1) { const float t = __shfl_up(g, o); if (lane >= o) g += t; }
        gcl[dir * 64 + lane] = g; bel[dir * 64 + lane] = BETA[tok * 8 + dir * 4 + h]; }
    LDS_BARRIER();
    { const int prod = C.wave >> 2, ti = (C.wave >> 1) & 1, tj = C.wave & 1, r = lane & 31, hh = lane >> 5;
      f32x16_t acc;
#pragma unroll
      for (int e = 0; e < 16; ++e) acc[e] = 0.f;
      const LAS unsigned char* Ab = (prod ? Qs : Ks) + (32 * ti + r) * 272 + hh * 16; const LAS unsigned char* Bb = Ks + (32 * tj + r) * 272 + hh * 16;
#pragma unroll
      for (int ks = 0; ks < 8; ++ks) { const bf16x8_t a = *(const LAS bf16x8_t*)(Ab + ks * 32), bb = *(const LAS bf16x8_t*)(Bb + ks * 32); acc = __builtin_amdgcn_mfma_f32_32x32x16_bf16(a, bb, acc, 0, 0, 0); }
      LAS float* dst = prod ? QKf : KKf;
#pragma unroll
      for (int e = 0; e < 16; ++e) dst[(32 * ti + (e & 3) + 8 * (e >> 2) + 4 * hh) * 65 + 32 * tj + r] = acc[e]; }
    LDS_BARRIER();
#pragma unroll
    for (int m = 0; m < 2; ++m) { const int e = tid + 512 * m, r = e >> 4, p = e & 15; *(LAS u32x4*)(Qs + r * 272 + p * 16) = vpre[m]; }
    const int dir = C.wave >> 2, t = tid & 255;
    const int cs = (dir ? 31 - c : c) * 64 + ((b * 4 + h) * 2 + dir);
    { bf16* qkd = (bf16*)(P.ws + WS_QKD) + (size_t)cs * 4096;
#pragma unroll
      for (int n = 0; n < 8; ++n) { const int e = 2 * (t + 256 * n), ip = e >> 6, jp = e & 63, i = dir ? 63 - ip : ip; float qv[2];
#pragma unroll
          for (int c2 = 0; c2 < 2; ++c2) { const int jq = jp + c2, j = dir ? 63 - jq : jq;
              const float dec = jq <= ip ? __expf(gcl[dir * 64 + ip] - gcl[dir * 64 + jq]) : 0.f;
              Ad[dir * 4096 + ip * 64 + jq] = jq < ip ? bel[dir * 64 + ip] * KKf[i * 65 + j] * dec : 0.f;
              qv[c2] = QKf[i * 65 + j] * dec; }
          *(unsigned*)(qkd + ip * 64 + jp) = pk2(qv[0], qv[1]); }
      if (t < 64) ((float*)(P.ws + WS_GCL))[(size_t)cs * 64 + t] = gcl[dir * 64 + t]; }
    LDS_BARRIER();
    { f32x2_t sol[32];
      const LAS float* gd = gcl + dir * 64; const LAS float* bd = bel + dir * 64;
      const int rstep = dir ? -272 : 272;
      if (t < 128) { const LAS unsigned char* vp = Qs + (dir ? 63 * 272 : 0) + t * 2;
#pragma unroll
          for (int ip = 0; ip < 64; ++ip) sol[ip >> 1][ip & 1] = bf2f(*(const LAS bf16*)(vp + ip * rstep)) * bd[ip];
      } else { const LAS unsigned char* kp = Ks + (dir ? 63 * 272 : 0) + (t - 128) * 2;
#pragma unroll
          for (int ip = 0; ip < 64; ++ip) sol[ip >> 1][ip & 1] = bf2f(*(const LAS bf16*)(kp + ip * rstep)) * bd[ip] * __expf(gd[ip]);
      }
      const LAS float* Ar = Ad + dir * 4096;
#pragma unroll 1
      for (int rb = 0; rb < 32; ++rb) {
          switch (rb) {
          case 0: b1_rows<0, 2>(sol, Ar); break;
          case 1: b1_rows<2, 2>(sol, Ar); break;
          case 2: b1_rows<4, 2>(sol, Ar); break;
          case 3: b1_rows<6, 2>(sol, Ar); break;
          case 4: b1_rows<8, 2>(sol, Ar); break;
          case 5: b1_rows<10, 2>(sol, Ar); break;
          case 6: b1_rows<12, 2>(sol, Ar); break;
          case 7: b1_rows<14, 2>(sol, Ar); break;
          case 8: b1_rows<16, 2>(sol, Ar); break;
          case 9: b1_rows<18, 2>(sol, Ar); break;
          case 10: b1_rows<20, 2>(sol, Ar); break;
          case 11: b1_rows<22, 2>(sol, Ar); break;
          case 12: b1_rows<24, 2>(sol, Ar); break;
          case 13: b1_rows<26, 2>(sol, Ar); break;
          case 14: b1_rows<28, 2>(sol, Ar); break;
          case 15: b1_rows<30, 2>(sol, Ar); break;
          case 16: b1_rows<32, 2>(sol, Ar); break;
          case 17: b1_rows<34, 2>(sol, Ar); break;
          case 18: b1_rows<36, 2>(sol, Ar); break;
          case 19: b1_rows<38, 2>(sol, Ar); break;
          case 20: b1_rows<40, 2>(sol, Ar); break;
          case 21: b1_rows<42, 2>(sol, Ar); break;
          case 22: b1_rows<44, 2>(sol, Ar); break;
          case 23: b1_rows<46, 2>(sol, Ar); break;
          case 24: b1_rows<48, 2>(sol, Ar); break;
          case 25: b1_rows<50, 2>(sol, Ar); break;
          case 26: b1_rows<52, 2>(sol, Ar); break;
          case 27: b1_rows<54, 2>(sol, Ar); break;
          case 28: b1_rows<56, 2>(sol, Ar); break;
          case 29: b1_rows<58, 2>(sol, Ar); break;
          case 30: b1_rows<60, 2>(sol, Ar); break;
          case 31: b1_rows<62, 2>(sol, Ar); break;
          default: break; }
      }
      LDS_BARRIER();
      LAS unsigned char* img = L + 34816 + dir * 32768;
      const float sg = t < 128 ? 1.f : -1.f;
#pragma unroll
      for (int ip = 0; ip < 64; ++ip) *(LAS bf16*)(img + ip * 512 + t * 2) = (bf16)f2bf(sg * sol[ip >> 1][ip & 1]); }
    LDS_BARRIER();
    { const LAS unsigned char* img = L + 34816 + dir * 32768;
      bf16* Ud = (bf16*)(P.ws + WS_U) + (size_t)cs * 8192; bf16* Nd = (bf16*)(P.ws + WS_NW) + (size_t)cs * 8192;
#pragma unroll
      for (int m = 0; m < 8; ++m) { const int e = t + 256 * m, row = e >> 5, p = e & 31; const u32x4 w = *(const LAS u32x4*)(img + row * 512 + p * 16);
          *(u32x4*)((p < 16 ? Ud : Nd) + row * 128 + (p & 15) * 8) = w; } }
    LDS_BARRIER();
}

constexpr int B2_NW = 0, B2_QG = 17408, B2_QK = 34816, B2_KGT = 44032, B2_EGL = 62464, B2_BUF = 62976;
struct B2Regs { u32x4 nw[2], qk, qv[2], kv[2]; float gq[2], gk, glast; };
__device__ __forceinline__ void b2_load(const Params& P, int chain, int n, int tid_, B2Regs& R) {
    int tid = tid_; asm volatile("" : "+v"(tid));
    const int b = chain >> 3, h = (chain >> 1) & 3, dir = chain & 1, cs = n * 64 + chain, c = dir ? 31 - n : n;
    const size_t tok0 = (size_t)b * SEQ + c * 64;
    const float* gcl = (const float*)(P.ws + WS_GCL) + (size_t)cs * 64;
    const bf16* NWg = (const bf16*)(P.ws + WS_NW) + (size_t)cs * 8192; const bf16* QKg = (const bf16*)(P.ws + WS_QKD) + (size_t)cs * 4096;
    const bf16* QB = (const bf16*)(P.ws + WS_QB); const bf16* KB = (const bf16*)(P.ws + WS_KB);
#pragma unroll
    for (int m = 0; m < 2; ++m) R.nw[m] = *(const u32x4*)(NWg + (tid + 512 * m) * 8);
    R.qk = *(const u32x4*)(QKg + tid * 8);
#pragma unroll
    for (int m = 0; m < 2; ++m) { const int e = tid + 512 * m, ip = e >> 4, p = e & 15, i = dir ? 63 - ip : ip; R.qv[m] = *(const u32x4*)(QB + (tok0 + i) * 512 + h * 128 + p * 8); R.gq[m] = gcl[ip]; }
#pragma unroll
    for (int m = 0; m < 2; ++m) { const int e = tid + 512 * m, ip = e & 63, p = e >> 6, i = dir ? 63 - ip : ip; R.kv[m] = *(const u32x4*)(KB + (tok0 + i) * 512 + h * 128 + p * 8); }
    R.gk = gcl[tid & 63]; R.glast = gcl[63];
}
__device__ __forceinline__ void b2_write(const B2Regs& R, LAS unsigned char* buf, int tid_) {
    int tid = tid_; asm volatile("" : "+v"(tid));
#pragma unroll
    for (int m = 0; m < 2; ++m) { const int e = tid + 512 * m, r = e >> 4, p = e & 15; *(LAS u32x4*)(buf + B2_NW + r * 272 + p * 16) = R.nw[m]; }
    { const int r = tid >> 3, p = tid & 7; *(LAS u32x4*)(buf + B2_QK + r * 144 + p * 16) = R.qk; }
#pragma unroll
    for (int m = 0; m < 2; ++m) { const int e = tid + 512 * m, ip = e >> 4, p = e & 15; const u32x4 q = R.qv[m]; const float s = __expf(R.gq[m]);
        u32x4 o; o.x = cvtpk(bflo(q.x) * s, bfhi(q.x) * s); o.y = cvtpk(bflo(q.y) * s, bfhi(q.y) * s); o.z = cvtpk(bflo(q.z) * s, bfhi(q.z) * s); o.w = cvtpk(bflo(q.w) * s, bfhi(q.w) * s);
        *(LAS u32x4*)(buf + B2_QG + ip * 272 + p * 16) = o; }
    const float sk = __expf(R.glast - R.gk);
#pragma unroll
    for (int m = 0; m < 2; ++m) { const int e = tid + 512 * m, ip = e & 63, p = e >> 6; const u32x4 k = R.kv[m];
        LAS bf16* d = (LAS bf16*)(buf + B2_KGT) + (8 * p) * 72 + ip;
        d[0] = (bf16)f2bf(bflo(k.x) * sk); d[72] = (bf16)f2bf(bfhi(k.x) * sk); d[144] = (bf16)f2bf(bflo(k.y) * sk); d[216] = (bf16)f2bf(bfhi(k.y) * sk);
        d[288] = (bf16)f2bf(bflo(k.z) * sk); d[360] = (bf16)f2bf(bfhi(k.z) * sk); d[432] = (bf16)f2bf(bflo(k.w) * sk); d[504] = (bf16)f2bf(bfhi(k.w) * sk); }
    if (tid == 0) *(LAS float*)(buf + B2_EGL) = __expf(R.glast);
}
__device__ __forceinline__ bf16x8_t ldA(const LAS unsigned char* p) {
    const s16x4_t lo = *(const LAS s16x4_t*)p, hi = *(const LAS s16x4_t*)(p + 32);
    return (bf16x8_t){lo[0], lo[1], lo[2], lo[3], hi[0], hi[1], hi[2], hi[3]};
}
__device__ __forceinline__ bf16x8_t packB(const f32x4& a, const f32x4& b) {
    u32x4 w; w.x = cvtpk(a[0], a[1]); w.y = cvtpk(a[2], a[3]); w.z = cvtpk(b[0], b[1]); w.w = cvtpk(b[2], b[3]);
    return __builtin_bit_cast(bf16x8_t, w);
}
#define B2_PIPE(N) do { __builtin_amdgcn_sched_group_barrier(0x100, 4, 0); _Pragma("unroll") for (int i_ = 0; i_ < (N) - 4; ++i_) { __builtin_amdgcn_sched_group_barrier(0x008, 1, 0); __builtin_amdgcn_sched_group_barrier(0x100, 1, 0); } \
    __builtin_amdgcn_sched_group_barrier(0x008, 4, 0); } while (0)

template <int O0, int O1, int O2, int O3, int O4, int O5, int O6, int O7>
__device__ __forceinline__ void rd8(s16x4_t (&d)[8], unsigned base) {
    asm volatile("ds_read_b64 %0, %8 offset:%9\n\tds_read_b64 %1, %8 offset:%10\n\tds_read_b64 %2, %8 offset:%11\n\tds_read_b64 %3, %8 offset:%12\n\t"
                 "ds_read_b64 %4, %8 offset:%13\n\tds_read_b64 %5, %8 offset:%14\n\tds_read_b64 %6, %8 offset:%15\n\tds_read_b64 %7, %8 offset:%16"
                 : "=&v"(d[0]), "=&v"(d[1]), "=&v"(d[2]), "=&v"(d[3]), "=&v"(d[4]), "=&v"(d[5]), "=&v"(d[6]), "=&v"(d[7])
                 : "v"(base), "n"(O0), "n"(O1), "n"(O2), "n"(O3), "n"(O4), "n"(O5), "n"(O6), "n"(O7) : "memory");
}
struct Frag8 { s16x4_t lo[8], hi[8]; };
template <int OFF, int STEP_T, int KS2> __device__ __forceinline__ void frag_issue(Frag8& f, unsigned base) {
    rd8<OFF, OFF + STEP_T, OFF + 2 * STEP_T, OFF + 3 * STEP_T, OFF + KS2, OFF + KS2 + STEP_T, OFF + KS2 + 2 * STEP_T, OFF + KS2 + 3 * STEP_T>(f.lo, base);
    rd8<OFF + 32, OFF + STEP_T + 32, OFF + 2 * STEP_T + 32, OFF + 3 * STEP_T + 32, OFF + KS2 + 32, OFF + KS2 + STEP_T + 32, OFF + KS2 + 2 * STEP_T + 32, OFF + KS2 + 3 * STEP_T + 32>(f.hi, base);
}
__device__ __forceinline__ void frag_wait(Frag8& f) {
    asm volatile("s_waitcnt lgkmcnt(0)" : "+v"(f.lo[0]), "+v"(f.lo[1]), "+v"(f.lo[2]), "+v"(f.lo[3]), "+v"(f.lo[4]), "+v"(f.lo[5]), "+v"(f.lo[6]), "+v"(f.lo[7]) :: "memory");
    asm volatile("s_waitcnt lgkmcnt(0)" : "+v"(f.hi[0]), "+v"(f.hi[1]), "+v"(f.hi[2]), "+v"(f.hi[3]), "+v"(f.hi[4]), "+v"(f.hi[5]), "+v"(f.hi[6]), "+v"(f.hi[7]) :: "memory");
}
__device__ __forceinline__ bf16x8_t frag_get(const Frag8& f, int i) { return (bf16x8_t){f.lo[i][0], f.lo[i][1], f.lo[i][2], f.lo[i][3], f.hi[i][0], f.hi[i][1], f.hi[i][2], f.hi[i][3]}; }
template <int OFF, int STRIDE, int T0, int KS> __device__ __forceinline__ void b2_rd4(bf16x8_t (&A)[8], int slot, const LAS unsigned char* const (&q)[4]) {
#pragma unroll
    for (int t = 0; t < 4; ++t) { const int o = OFF + (16 * (T0 + t)) * STRIDE + 64 * (KS & ~1);
        const s16x4_t lo = *(const LAS s16x4_t*)(q[2 * (KS & 1)] + o), hi = *(const LAS s16x4_t*)(q[2 * (KS & 1) + 1] + o);
        A[slot + t] = (bf16x8_t){lo[0], lo[1], lo[2], lo[3], hi[0], hi[1], hi[2], hi[3]}; }
}
__device__ __forceinline__ void b2_step(LAS unsigned char* buf, f32x4 (&S)[8], const u32x4 (&uq)[2], LAS unsigned char* scr, bf16* Orow, int lane, int g, int l15) {
    *(LAS u32x4*)(scr + lane * 32) = uq[0]; *(LAS u32x4*)(scr + lane * 32 + 16) = uq[1];
    LDS_WAIT();
    unsigned short ur[4][4];
#pragma unroll
    for (int t = 0; t < 4; ++t)
#pragma unroll
        for (int r = 0; r < 4; ++r) ur[t][r] = *(const LAS bf16*)(scr + (16 * t + 4 * g + r) * 32 + l15 * 2);
    const LAS unsigned char* b272[4]; const LAS unsigned char* b144[4];
#pragma unroll
    for (int i = 0; i < 4; ++i) { b272[i] = buf + l15 * 272 + g * 8 + 32 * i; b144[i] = buf + l15 * 144 + g * 8 + 32 * i; asm volatile("" : "+v"(b272[i]), "+v"(b144[i])); }
    bf16x8_t A0[8], A1[8];
    b2_rd4<B2_NW, 272, 0, 0>(A0, 0, b272); b2_rd4<B2_NW, 272, 0, 1>(A0, 4, b272);
    f32x4 vn[4];
#pragma unroll
    for (int t = 0; t < 4; ++t)
#pragma unroll
        for (int r = 0; r < 4; ++r) vn[t][r] = bf2f(ur[t][r]);
    bf16x8_t Sb[4];
#pragma unroll
    for (int ks = 0; ks < 4; ++ks) Sb[ks] = packB(S[2 * ks], S[2 * ks + 1]);
    __builtin_amdgcn_sched_barrier(0);
    b2_rd4<B2_NW, 272, 0, 2>(A1, 0, b272); b2_rd4<B2_NW, 272, 0, 3>(A1, 4, b272);
#pragma unroll
    for (int i = 0; i < 8; ++i) vn[i & 3] = __builtin_amdgcn_mfma_f32_16x16x32_bf16(A0[i], Sb[i >> 2], vn[i & 3], 0, 0, 0);
    __builtin_amdgcn_sched_barrier(0);
    b2_rd4<B2_QG, 272, 0, 0>(A0, 0, b272); b2_rd4<B2_QG, 272, 0, 1>(A0, 4, b272);
#pragma unroll
    for (int i = 0; i < 8; ++i) vn[i & 3] = __builtin_amdgcn_mfma_f32_16x16x32_bf16(A1[i], Sb[2 + (i >> 2)], vn[i & 3], 0, 0, 0);
    __builtin_amdgcn_sched_barrier(0);
    bf16x8_t vb[2];
#pragma unroll
    for (int ks = 0; ks < 2; ++ks) vb[ks] = packB(vn[2 * ks], vn[2 * ks + 1]);
    f32x4 o[4];
#pragma unroll
    for (int t = 0; t < 4; ++t) o[t] = (f32x4){0.f, 0.f, 0.f, 0.f};
    b2_rd4<B2_QG, 272, 0, 2>(A1, 0, b272); b2_rd4<B2_QG, 272, 0, 3>(A1, 4, b272);
#pragma unroll
    for (int i = 0; i < 8; ++i) o[i & 3] = __builtin_amdgcn_mfma_f32_16x16x32_bf16(A0[i], Sb[i >> 2], o[i & 3], 0, 0, 0);
    __builtin_amdgcn_sched_barrier(0);
    b2_rd4<B2_QK, 144, 0, 0>(A0, 0, b144); b2_rd4<B2_QK, 144, 0, 1>(A0, 4, b144);
#pragma unroll
    for (int i = 0; i < 8; ++i) o[i & 3] = __builtin_amdgcn_mfma_f32_16x16x32_bf16(A1[i], Sb[2 + (i >> 2)], o[i & 3], 0, 0, 0);
    __builtin_amdgcn_sched_barrier(0);
    b2_rd4<B2_KGT, 144, 0, 0>(A1, 0, b144); b2_rd4<B2_KGT, 144, 4, 0>(A1, 4, b144);
#pragma unroll
    for (int i = 0; i < 8; ++i) o[i & 3] = __builtin_amdgcn_mfma_f32_16x16x32_bf16(A0[i], vb[i >> 2], o[i & 3], 0, 0, 0);
    __builtin_amdgcn_sched_barrier(0);
#pragma unroll
    for (int t = 0; t < 4; ++t)
#pragma unroll
        for (int r = 0; r < 4; ++r) *(LAS bf16*)(scr + (16 * t + 4 * g + r) * 32 + l15 * 2) = (bf16)f2bf(o[t][r]);
    LDS_WAIT();
    { const u32x4 w0 = *(const LAS u32x4*)(scr + lane * 32), w1 = *(const LAS u32x4*)(scr + lane * 32 + 16); *(u32x4*)Orow = w0; *(u32x4*)(Orow + 8) = w1; }
    const float egl = *(const LAS float*)(buf + B2_EGL);
#pragma unroll
    for (int t = 0; t < 8; ++t) S[t] = S[t] * egl;
    b2_rd4<B2_KGT, 144, 0, 1>(A0, 0, b144); b2_rd4<B2_KGT, 144, 4, 1>(A0, 4, b144);
#pragma unroll
    for (int i = 0; i < 8; ++i) S[i] = __builtin_amdgcn_mfma_f32_16x16x32_bf16(A1[i], vb[0], S[i], 0, 0, 0);
    __builtin_amdgcn_sched_barrier(0);
#pragma unroll
    for (int i = 0; i < 8; ++i) S[i] = __builtin_amdgcn_mfma_f32_16x16x32_bf16(A0[i], vb[1], S[i], 0, 0, 0);
}
__device__ __forceinline__ void b2_uload(const bf16* Urow, u32x4 (&uq)[2]) { uq[0] = *(const u32x4*)Urow; uq[1] = *(const u32x4*)(Urow + 8); }
__device__ __forceinline__ void b2_chain(const Params& P, const Ctx& C, int chain) {
    const int b = chain >> 3, h = (chain >> 1) & 3, dir = chain & 1;
    int tid_ = C.tid; asm volatile("" : "+v"(tid_)); const int tid = tid_, lane = tid & 63, g = lane >> 4, l15 = lane & 15;
    LAS unsigned char* base = C.lds;
    const int v0 = 16 * C.wave;
    const bf16* Ug = (const bf16*)(P.ws + WS_U) + (size_t)chain * 8192 + lane * 128 + v0;
    bf16* OUT = (bf16*)(P.ws + (dir ? WS_OB : WS_OF)) + (size_t)b * SEQ * 512 + (dir ? 63 - lane : lane) * 512 + h * 128 + v0;
    LAS unsigned char* scr = base + 2 * B2_BUF + C.wave * 2048;
    B2Regs R0, R1;
    u32x4 u0[2], u1[2];
    f32x4 S[8];
#pragma unroll
    for (int t = 0; t < 8; ++t) S[t] = (f32x4){0.f, 0.f, 0.f, 0.f};
    b2_load(P, chain, 0, tid, R0); b2_uload(Ug, u0);
    b2_load(P, chain, 1, tid, R1); b2_uload(Ug + (size_t)64 * 8192, u1);
    b2_write(R0, base, tid);
    LDS_BARRIER();
    for (int n = 0; n < 32; n += 2) {
        if (n + 2 < 32) b2_load(P, chain, n + 2, tid, R0);
        { const int c = dir ? 31 - n : n; b2_step(base, S, u0, scr, OUT + (size_t)c * 64 * 512, lane, g, l15); }
        if (n + 2 < 32) b2_uload(Ug + (size_t)(n + 2) * 64 * 8192, u0);
        b2_write(R1, base + B2_BUF, tid);
        LDS_BARRIER();
        if (n + 3 < 32) b2_load(P, chain, n + 3, tid, R1);
        { const int c = dir ? 31 - (n + 1) : n + 1; b2_step(base + B2_BUF, S, u1, scr, OUT + (size_t)c * 64 * 512, lane, g, l15); }
        if (n + 3 < 32) b2_uload(Ug + (size_t)(n + 3) * 64 * 8192, u1);
        if (n + 2 < 32) b2_write(R0, base, tid);
        LDS_BARRIER();
    }
}

constexpr int AT_K = 0, AT_V = 9216, AT_BUF = 18432, AT_ITEM = 40960;
template <int MODE>
__device__ __forceinline__ void attn_item(const Params& P, const Ctx& C, int item) {
    constexpr bool IS_A = MODE == 1;
    int tid_ = C.tid; asm volatile("" : "+v"(tid_)); const int tid = tid_, lane = tid & 63, r = lane & 31, hh = lane >> 5; const int wave = C.wave;
    LAS unsigned char* L = C.lds;
    const bf16* PROJ = (const bf16*)(P.ws + WS_PROJ); bf16* MIX = (bf16*)(P.ws + WS_MIX);
    int b, tw, qcol, kcol, vcol, ocol, kt_lo, kt_hi, hA = 0, rres = 0; const bf16* VT;
    if (MODE == 1) { b = item >> 5; const int h = (item >> 3) & 3, q0 = (item & 7) * 256; hA = h; VT = (const bf16*)(P.ws + WS_VTA) + ((size_t)(b * 4 + h) * 64) * SEQ; tw = q0 + 32 * wave; qcol = PC_QA + 64 * h; kcol = PC_KA + 64 * h; vcol = PC_VA + 64 * h; ocol = 64 * h;
        kt_lo = q0 - 256 < 0 ? 0 : (q0 - 256) >> 6; kt_hi = ((q0 + 511) >> 6) + 1; if (kt_hi > 32) kt_hi = 32; }
    else if (MODE == 2) { b = item >> 6; const int h = (item >> 4) & 3; hA = h; rres = item & 15; VT = (const bf16*)(P.ws + WS_VT3) + ((size_t)((b * 4 + h) * 16 + rres) * 64) * 128; tw = 32 * (wave & 3); qcol = PC_QA + 64 * h; kcol = PC_KA + 64 * h; vcol = 0; ocol = 0;
        kt_lo = 0; kt_hi = 2; }
    else { b = item >> 5; const int kvh = (item >> 4) & 1, q0 = (item & 15) * 128, qh = kvh * 2 + (wave >> 2); VT = (const bf16*)(P.ws + WS_VTC) + ((size_t)(b * 2 + kvh) * 64) * SEQ; tw = q0 + 32 * (wave & 3); qcol = PC_QC + 64 * qh; kcol = PC_KC + 64 * kvh; vcol = PC_VC + 64 * kvh; ocol = 768 + 64 * qh;
        kt_lo = 0; kt_hi = 32; }
    const size_t tokb = (size_t)b * SEQ;
    const int q = tw + r;
    bf16x8_t qf[4];
    const size_t qtok = tokb + (MODE == 2 ? rres + 16 * q : q);
#pragma unroll
    for (int s4 = 0; s4 < 4; ++s4) qf[s4] = *(const bf16x8_t*)(PROJ + qtok * NPROJ + qcol + 16 * s4 + 8 * hh);
    unsigned mask16 = 0u, mask4 = 0u;
    if (IS_A) {
#pragma unroll
        for (int e = 0; e < 16; ++e) { const int kr = (e & 3) + 8 * (e >> 2) + 4 * hh; const int d = kr - q;
            if ((d & 15) == 0) mask16 |= (1u << e) | (1u << (16 + e)); if ((d & 3) == 0) mask4 |= (1u << e) | (1u << (16 + e)); }
    }
    const int kkey = tid >> 3, kp = tid & 7;
    constexpr size_t KSTEP = (MODE == 2 ? 16 : 1) * (size_t)64 * NPROJ;
    const bf16* ksrc = PROJ + (tokb + (MODE == 2 ? rres + 16 * kkey : kkey)) * NPROJ + kcol + 8 * kp; const bf16* vsrc = VT + (size_t)kkey * (MODE == 2 ? 128 : SEQ) + 8 * kp;
    const int kdst = AT_K + kkey * 144 + kp * 16, vdst = AT_V + kkey * 144 + kp * 16;
    u32x4 kreg = *(const u32x4*)(ksrc + (size_t)kt_lo * KSTEP), vreg = *(const u32x4*)(vsrc + kt_lo * 64);
#define AT_WRITE(bufo) do { *(LAS u32x4*)(L + (bufo) + kdst) = kreg; *(LAS u32x4*)(L + (bufo) + vdst) = vreg; } while (0)
    AT_WRITE(0);
    f32x16_t o0, o1;
#pragma unroll
    for (int e = 0; e < 16; ++e) { o0[e] = 0.f; o1[e] = 0.f; }
    float m = -INFINITY, l = 0.f;
    float* part = (float*)((unsigned char*)(P.ws + WS_PROJ) + qtok * (size_t)(NPROJ * 2) + PC_QB * 2) + hA * 68;
    if (MODE == 1) { m = part[64]; l = hh == 0 ? part[65] : 0.f;
#pragma unroll
        for (int g4 = 0; g4 < 4; ++g4) { const f32x4 a = *(const f32x4*)(part + 8 * g4 + 4 * hh), c4 = *(const f32x4*)(part + 32 + 8 * g4 + 4 * hh);
#pragma unroll
            for (int e = 0; e < 4; ++e) { o0[4 * g4 + e] = a[e]; o1[4 * g4 + e] = c4[e]; } } }
    __syncthreads();
    for (int kt = kt_lo; kt < kt_hi; ++kt) {
        const int cur = ((kt - kt_lo) & 1) * AT_BUF;
        if (kt + 1 < kt_hi) { kreg = *(const u32x4*)(ksrc + (size_t)(kt + 1) * KSTEP); vreg = *(const u32x4*)(vsrc + (kt + 1) * 64); }
        const int k0 = kt * 64;
        const int dlo = k0 - (tw + 31), dhi = k0 + 63 - tw;
        const int dmin = dlo > 0 ? dlo : (dhi < 0 ? -dhi : 0), dmax = -dlo > dhi ? -dlo : dhi;
        if ((MODE != 1 || dmin <= 256) && !(MODE == 2 && wave >= 4)) {
            f32x16_t s0, s1;
#pragma unroll
            for (int e = 0; e < 16; ++e) { s0[e] = 0.f; s1[e] = 0.f; }
            const LAS unsigned char* kb = L + cur + AT_K + r * 144 + hh * 16;
#pragma unroll
            for (int s4 = 0; s4 < 4; ++s4) { const bf16x8_t a0 = *(const LAS bf16x8_t*)(kb + s4 * 32), a1 = *(const LAS bf16x8_t*)(kb + 32 * 144 + s4 * 32);
                s0 = __builtin_amdgcn_mfma_f32_32x32x16_bf16(a0, qf[s4], s0, 0, 0, 0); s1 = __builtin_amdgcn_mfma_f32_32x32x16_bf16(a1, qf[s4], s1, 0, 0, 0); }
            float w0[16], w1[16];
            if (IS_A) {
#pragma unroll
                for (int e = 0; e < 16; ++e) { const int kr = (e & 3) + 8 * (e >> 2) + 4 * hh;
                    { const int d = k0 + kr - q, ad = d < 0 ? -d : d; w0[e] = (ad <= 64 ? 1.f : 0.f) + (((mask4 >> e) & 1u) && ad <= 256 ? 1.f : 0.f); }
                    { const int d = k0 + 32 + kr - q, ad = d < 0 ? -d : d; w1[e] = (ad <= 64 ? 1.f : 0.f) + (((mask4 >> e) & 1u) && ad <= 256 ? 1.f : 0.f); } }
#pragma unroll
                for (int e = 0; e < 16; ++e) { if (w0[e] == 0.f) s0[e] = -INFINITY; if (w1[e] == 0.f) s1[e] = -INFINITY; }
            }
            if (MODE == 2 && dmax > 64) {
#pragma unroll
                for (int e = 0; e < 16; ++e) { const int kr = (e & 3) + 8 * (e >> 2) + 4 * hh;
                    { const int d = k0 + kr - q, ad = d < 0 ? -d : d; if (ad > 64) s0[e] = -INFINITY; }
                    { const int d = k0 + 32 + kr - q, ad = d < 0 ? -d : d; if (ad > 64) s1[e] = -INFINITY; } }
            }
            float mx = fmaxf(s0[0], s1[0]);
#pragma unroll
            for (int e = 1; e < 16; ++e) mx = fmaxf(mx, fmaxf(s0[e], s1[e]));
            mx = fmaxf(mx, __shfl_xor(mx, 32));
            const float mn = fmaxf(m, mx), mu = mn == -INFINITY ? 0.f : mn;
            const float alpha = __builtin_amdgcn_exp2f(m - mu);
            float ps = 0.f;
#pragma unroll
            for (int e = 0; e < 16; ++e) { float p0 = __builtin_amdgcn_exp2f(s0[e] - mu), p1 = __builtin_amdgcn_exp2f(s1[e] - mu); if (IS_A) { p0 *= w0[e]; p1 *= w1[e]; } s0[e] = p0; s1[e] = p1; ps += p0 + p1; }
            l = l * alpha + ps; m = mn;
#pragma unroll
            for (int e = 0; e < 16; ++e) { o0[e] *= alpha; o1[e] *= alpha; }
            bf16x8_t pb[2][2];
#pragma unroll
            for (int s2 = 0; s2 < 2; ++s2) {
                u32x4 w; w.x = cvtpk(s0[8 * s2], s0[8 * s2 + 1]); w.y = cvtpk(s0[8 * s2 + 2], s0[8 * s2 + 3]); w.z = cvtpk(s0[8 * s2 + 4], s0[8 * s2 + 5]); w.w = cvtpk(s0[8 * s2 + 6], s0[8 * s2 + 7]); pb[0][s2] = __builtin_bit_cast(bf16x8_t, w);
                w.x = cvtpk(s1[8 * s2], s1[8 * s2 + 1]); w.y = cvtpk(s1[8 * s2 + 2], s1[8 * s2 + 3]); w.z = cvtpk(s1[8 * s2 + 4], s1[8 * s2 + 5]); w.w = cvtpk(s1[8 * s2 + 6], s1[8 * s2 + 7]); pb[1][s2] = __builtin_bit_cast(bf16x8_t, w); }
            const LAS unsigned char* vq[8];
#pragma unroll
            for (int i = 0; i < 8; ++i) { vq[i] = L + cur + AT_V + r * 144 + hh * 8 + 16 * i; asm volatile("" : "+v"(vq[i])); }
#pragma unroll
            for (int u = 0; u < 2; ++u)
#pragma unroll
                for (int s2 = 0; s2 < 2; ++s2) { const int ki = 2 * (2 * u + s2);
                    const s16x4_t lo0 = *(const LAS s16x4_t*)(vq[ki]), hi0 = *(const LAS s16x4_t*)(vq[ki + 1]), lo1 = *(const LAS s16x4_t*)(vq[ki] + 32 * 144), hi1 = *(const LAS s16x4_t*)(vq[ki + 1] + 32 * 144);
                    const bf16x8_t a0 = (bf16x8_t){lo0[0], lo0[1], lo0[2], lo0[3], hi0[0], hi0[1], hi0[2], hi0[3]}, a1 = (bf16x8_t){lo1[0], lo1[1], lo1[2], lo1[3], hi1[0], hi1[1], hi1[2], hi1[3]};
                    o0 = __builtin_amdgcn_mfma_f32_32x32x16_bf16(a0, pb[u][s2], o0, 0, 0, 0); o1 = __builtin_amdgcn_mfma_f32_32x32x16_bf16(a1, pb[u][s2], o1, 0, 0, 0); }
        }
        if (kt + 1 < kt_hi) AT_WRITE(cur ^ AT_BUF);
        __syncthreads();
    }
#undef AT_WRITE
    const float lt = l + __shfl_xor(l, 32);
    if (MODE == 2) {
        if (wave < 4) {
#pragma unroll
            for (int g4 = 0; g4 < 4; ++g4) { *(f32x4*)(part + 8 * g4 + 4 * hh) = (f32x4){o0[4 * g4], o0[4 * g4 + 1], o0[4 * g4 + 2], o0[4 * g4 + 3]};
                *(f32x4*)(part + 32 + 8 * g4 + 4 * hh) = (f32x4){o1[4 * g4], o1[4 * g4 + 1], o1[4 * g4 + 2], o1[4 * g4 + 3]}; }
            if (hh == 0) { part[64] = m; part[65] = lt; } }
        return; }
    const float inv = __builtin_amdgcn_rcpf(lt);
    bf16* op = MIX + (tokb + q) * 1024 + ocol + 4 * hh;
#pragma unroll
    for (int g4 = 0; g4 < 4; ++g4) { u32x2 w; w.x = cvtpk(o0[4 * g4] * inv, o0[4 * g4 + 1] * inv); w.y = cvtpk(o0[4 * g4 + 2] * inv, o0[4 * g4 + 3] * inv); *(u32x2*)(op + 8 * g4) = w;
        w.x = cvtpk(o1[4 * g4] * inv, o1[4 * g4 + 1] * inv); w.y = cvtpk(o1[4 * g4 + 2] * inv, o1[4 * g4 + 3] * inv); *(u32x2*)(op + 32 + 8 * g4) = w; }
}
__device__ __forceinline__ void phase_b1(const Params& P, const Ctx& C, int L) {
    for (int item = blockIdx.x; item < 1024; item += gridDim.x) b1_item(P, C, item);
    for (int it = blockIdx.x; it < 512; it += gridDim.x) attn_item<2>(P, C, it);
}
__device__ __forceinline__ void phase_mix(const Params& P, const Ctx& C, int L, int rep) {
    unsigned* ctr = (unsigned*)(P.ws + WS_CTL) + 64 * L + 16 * rep;
    for (int chain = blockIdx.x; chain < 64; chain += gridDim.x) b2_chain(P, C, chain);
#if SPLIT_MX
    cg::this_grid().sync();
#endif
    for (;;) {
        if (C.tid == 0) *(LAS unsigned*)(C.lds + AT_ITEM) = atomicAdd(ctr, 1u);
        __syncthreads();
        const unsigned it = __builtin_amdgcn_readfirstlane(*(const LAS unsigned*)(C.lds + AT_ITEM));
        __syncthreads();
        if (it >= 512u) break;
        if (it < 256u) attn_item<1>(P, C, (int)it);
        else attn_item<0>(P, C, (int)it - 256);
    }
}

__device__ __forceinline__ void phase_finish(const Params& P, const Ctx& C, int L) {
    const bf16* OF = (const bf16*)(P.ws + WS_OF); const bf16* OB = (const bf16*)(P.ws + WS_OB); const bf16* PROJ = (const bf16*)(P.ws + WS_PROJ); bf16* MIX = (bf16*)(P.ws + WS_MIX);
    const f32x2_t on = *(const f32x2_t*)(P.in[I_ONORM] + L * 128 + 2 * C.lane);
    constexpr int FB = 8;
    for (int it0 = C.gw; it0 < M * 4; it0 += FB * C.ngw) {
        unsigned a[FB], bb[FB], zu[FB];
#pragma unroll
        for (int j = 0; j < FB; ++j) { const int it = it0 + j * C.ngw < M * 4 ? it0 + j * C.ngw : it0; const size_t tok = it >> 2; const int h = it & 3;
            a[j] = *(const unsigned*)(OF + tok * 512 + h * 128 + 2 * C.lane); bb[j] = *(const unsigned*)(OB + tok * 512 + h * 128 + 2 * C.lane); zu[j] = *(const unsigned*)(PROJ + tok * NPROJ + PC_ZB + h * 128 + 2 * C.lane); }
        float o0[FB], o1[FB], ss[FB];
#pragma unroll
        for (int j = 0; j < FB; ++j) { o0[j] = bflo(a[j]) + bflo(bb[j]); o1[j] = bfhi(a[j]) + bfhi(bb[j]); ss[j] = o0[j] * o0[j] + o1[j] * o1[j]; }
#pragma unroll
        for (int j = 0; j < FB; ++j) ss[j] = wave_sum(ss[j]);
#pragma unroll
        for (int j = 0; j < FB; ++j) { const int it = it0 + j * C.ngw; if (it < M * 4) { const size_t tok = it >> 2; const int h = it & 3;
            const float rs = __builtin_amdgcn_rsqf(ss[j] * (1.0f / 128.0f) + EPS); const float z0 = bflo(zu[j]), z1 = bfhi(zu[j]);
            *(unsigned*)(MIX + tok * 1024 + 256 + h * 128 + 2 * C.lane) = pk2(o0[j] * rs * on.x * z0 * __builtin_amdgcn_rcpf(1.0f + __expf(-z0)), o1[j] * rs * on.y * z1 * __builtin_amdgcn_rcpf(1.0f + __expf(-z1))); } }
    }
}

#ifndef SIMPLE_A
#define SIMPLE_A 0
#endif
#ifndef SPLIT_MX
#define SPLIT_MX 0
#endif
#ifndef REP
#define REP 0
#endif
#ifndef SKIP
#define SKIP 0
#endif
#define XB_TMO      128
#define XB_XCNT(j)  (256  + 64 * (j))
#define XB_XSUB(j)  (1280 + 64 * (j))
#define XB_XGEN(j)  (2304 + 64 * (j))
#define XB_TOP      3328
#define XB_TOPGEN   3392
#define XCD_BAR_WORDS 3456
#define XB_SPIN_CAP (1u << 18)

__device__ __forceinline__ unsigned xb_ld(unsigned* p)              { return __hip_atomic_load(p, __ATOMIC_RELAXED, __HIP_MEMORY_SCOPE_AGENT); }
__device__ __forceinline__ unsigned xb_add(unsigned* p, unsigned v) { return __hip_atomic_fetch_add(p, v, __ATOMIC_RELAXED, __HIP_MEMORY_SCOPE_AGENT); }
__device__ __forceinline__ unsigned xb_xcc_id() { return (unsigned)__builtin_amdgcn_s_getreg((3 << 11) | 20) & 0xFu; }
#define XB_SPIN(cond, bar) do { unsigned _sp = 0; while (cond) { __builtin_amdgcn_s_sleep(1); \
    if ((++_sp & 255u) == 0u) { if (xb_ld(&(bar)[XB_TMO])) break; if (_sp > XB_SPIN_CAP) { atomicAdd(&(bar)[XB_TMO], 1u); break; } } } } while (0)

struct XcdBarrier {
    unsigned* bar; unsigned x;
    volatile LAS unsigned* st;
};

__device__ __forceinline__ XcdBarrier xcd_barrier_post(unsigned* bar, volatile LAS unsigned* st) {
    XcdBarrier b; b.bar = bar; b.x = xb_xcc_id(); b.st = st;
    if (threadIdx.x == 0) (void)xb_add(&bar[XB_XCNT(b.x)], 1u);
    return b;
}
__device__ __forceinline__ void xcd_barrier_complete(unsigned* bar, unsigned x, unsigned& nloc, unsigned& nx) {
    const unsigned G = gridDim.x * gridDim.y * gridDim.z;
    unsigned sum, cnt, mine, sp = 0u;
    for (;;) {
        sum = 0u; cnt = 0u; mine = 0u;
#pragma unroll
        for (unsigned j = 0; j < 16; ++j) { const unsigned c = xb_ld(&bar[XB_XCNT(j)]); sum += c; cnt += (c > 0u) ? 1u : 0u; mine = (j == x) ? c : mine; }
        if (sum == G) break;
        __builtin_amdgcn_s_sleep(1);
        if ((++sp & 255u) == 0u) { if (xb_ld(&bar[XB_TMO])) break; if (sp > XB_SPIN_CAP) { atomicAdd(&bar[XB_TMO], 1u); break; } }
    }
    nloc = mine > 0u ? mine : 1u; nx = cnt > 0u ? cnt : 1u;
}

__device__ __forceinline__ void xcd_barrier(const XcdBarrier& b) {
    asm volatile("s_waitcnt vmcnt(0)" ::: "memory");
    __syncthreads();
    if (threadIdx.x == 0) {
        unsigned* bar = b.bar;
        __builtin_amdgcn_s_waitcnt(0);
        unsigned nloc = b.st[0], nx = b.st[1];
        if (nloc == 0u) { xcd_barrier_complete(bar, b.x, nloc, nx); b.st[0] = nloc; b.st[1] = nx; }
        const unsigned old = xb_add(&bar[XB_XSUB(b.x)], 1u);
        const unsigned gen = old / nloc;
        if (old + 1u == (gen + 1u) * nloc) {
            __builtin_amdgcn_fence(__ATOMIC_RELEASE, "agent");
            asm volatile("s_waitcnt vmcnt(0)" ::: "memory");
            const unsigned og = xb_add(&bar[XB_TOP], 1u);
            const unsigned tg = og / nx;
            if (og + 1u == (tg + 1u) * nx) xb_add(&bar[XB_TOPGEN], 1u);
            else XB_SPIN(xb_ld(&bar[XB_TOPGEN]) == tg, bar);
            __builtin_amdgcn_fence(__ATOMIC_ACQUIRE, "agent");
            xb_add(&bar[XB_XGEN(b.x)], 1u);
            asm volatile("s_waitcnt vmcnt(0)" ::: "memory");
        } else {
            XB_SPIN(xb_ld(&bar[XB_XGEN(b.x)]) == gen, bar);
            __builtin_amdgcn_fence(__ATOMIC_ACQUIRE, "agent");
            asm volatile("s_waitcnt vmcnt(0)" ::: "memory");
        }
    }
    __syncthreads();
}

__global__ void __launch_bounds__(512, 2) mega_fwd(Params P) {
    extern __shared__ __attribute__((aligned(16))) unsigned char lds[];
    cg::grid_group grid = cg::this_grid();
    { volatile LAS unsigned* st0 = (volatile LAS unsigned*)((LAS unsigned char*)lds + 147392); if (threadIdx.x < 2) st0[threadIdx.x] = 0u; }
    __syncthreads();
    XcdBarrier xbar = xcd_barrier_post((unsigned*)(P.ws + WS_CTL + 8192), (volatile LAS unsigned*)((LAS unsigned char*)lds + 147392));
    for (int ph = P.ph_lo; ph < P.ph_hi; ++ph) {
        const int L = ph / NPH, p = ph % NPH;
        const int nrep = ((REP >> p) & 1) ? 2 : 1;
        for (int rep = 0; rep < nrep; ++rep) {
        if (rep) xcd_barrier(xbar);
        int tid_ = threadIdx.x; asm volatile("" : "+v"(tid_));
        Ctx C; C.tid = tid_; C.lane = C.tid & 63; C.wave = __builtin_amdgcn_readfirstlane(C.tid >> 6); C.gw = blockIdx.x * 8 + C.wave; C.ngw = gridDim.x * 8; C.lds = (LAS unsigned char*)lds;
        unsigned char* ws = P.ws;
        if (p == 0) { if (!(SKIP & 1)) phase_n1(P, C, L); }
        else if (p == 1) { pg8::Gemm g{(const pg8::bf16_t*)(ws + WS_XN), (const pg8::bf16_t*)(ws + WS_WIN), M, NPROJ, DM}; pg8::StaticOrder S; S.init(M, NPROJ, gridDim.x, blockIdx.x);
            pg8::EpiStoreBf16 E{(pg8::bf16_t*)(ws + WS_PROJ), NPROJ}; pg8::gemm_phase<pg8::EpiStoreBf16, pg8::StaticOrder, true, true>(C.lds, g, S, E); }
        else if (p == 2) { if (!(SKIP & 2)) phase_prep(P, C, L); }
        else if (p == 3) { if (!(SKIP & 16)) phase_b1(P, C, L); }
        else if (p == 4) { if (!(SKIP & 4)) phase_mix(P, C, L, rep); }
        else if (p == 5) { if (!(SKIP & 8)) phase_finish(P, C, L); }
        else if (p == 6) { pg8::Gemm g{(const pg8::bf16_t*)(ws + WS_MIX), (const pg8::bf16_t*)(ws + WS_WO), M, DM, DM}; pg8::StaticOrder S; S.init(M, DM, gridDim.x, blockIdx.x);
            pg8::EpiResid E{L == 0 ? P.in[I_X] : P.out, (float*)(ws + WS_X1), DM}; pg8::gemm_phase<pg8::EpiResid, pg8::StaticOrder, true, true>(C.lds, g, S, E); }
        else if (p == 7) norm_rows<false>(P, C, L, (const float*)(ws + WS_X1), P.in[I_NORM2] + L * DM);
        else if (p == 8) { pg8::Gemm g{(const pg8::bf16_t*)(ws + WS_XN), (const pg8::bf16_t*)(ws + WS_WGU), M, NGU, DM}; pg8::StaticOrder S; S.init(M, NGU, gridDim.x, blockIdx.x);
            pg8::EpiSwiglu E{(pg8::bf16_t*)(ws + WS_PROJ), DFF}; pg8::gemm_phase<pg8::EpiSwiglu, pg8::StaticOrder, true, true>(C.lds, g, S, E); }
        else { pg8::Gemm g{(const pg8::bf16_t*)(ws + WS_PROJ), (const pg8::bf16_t*)(ws + WS_WD), M, DM, DFF}; pg8::StaticOrder S; S.init(M, DM, gridDim.x, blockIdx.x);
            pg8::EpiResid E{(const float*)(ws + WS_X1), P.out, DM}; pg8::gemm_phase<pg8::EpiResid, pg8::StaticOrder, true, true>(C.lds, g, S, E); }
        }
        if (ph + 1 < P.ph_hi) { if (ph == P.ph_lo) grid.sync(); else xcd_barrier(xbar); }
    }
}

#ifndef ONE_LAUNCH
#define ONE_LAUNCH 1
#endif
extern "C" void kernel_launch(void* const* d_in, const int* in_sizes, int n_in, void* d_out, int out_size, void* d_ws, size_t ws_size, hipStream_t stream) {
    static int grid = 0;
    if (!grid) {
        if (n_in != 15 || ws_size < WS_END) { fprintf(stderr, "kernel_launch: unexpected n_in %d / ws_size %zu (need %zu)\n", n_in, ws_size, (size_t)WS_END); return; }
        int dev = 0, cus = 0, per_cu = 0;
        hipGetDevice(&dev); hipDeviceGetAttribute(&cus, hipDeviceAttributeMultiprocessorCount, dev);
        hipFuncSetAttribute((const void*)mega_fwd, hipFuncAttributeMaxDynamicSharedMemorySize, LDS_BYTES);
        hipOccupancyMaxActiveBlocksPerMultiprocessor(&per_cu, mega_fwd, 512, LDS_BYTES);
        if (per_cu < 1) { fprintf(stderr, "kernel_launch: occupancy query says %d blocks per CU\n", per_cu); per_cu = 1; }
        grid = cus * per_cu;
    }
    Params p{};
    for (int i = 0; i < 15; ++i) p.in[i] = (const float*)d_in[i];
    p.out = (float*)d_out; p.ws = (unsigned char*)d_ws;
    hipMemsetAsync((char*)d_ws + WS_CTL, 0, 32768, stream);
#if ONE_LAUNCH
    p.ph_lo = 0; p.ph_hi = DEPTH * NPH;
    void* args[] = {&p};
    hipError_t e = hipLaunchCooperativeKernel((const void*)mega_fwd, dim3(grid), dim3(512), args, LDS_BYTES, stream);
    if (e != hipSuccess) fprintf(stderr, "cooperative launch failed: %s (grid %d)\n", hipGetErrorString(e), grid);
#else
    for (int ph = 0; ph < DEPTH * NPH; ++ph) { p.ph_lo = ph; p.ph_hi = ph + 1; hipLaunchKernelGGL(mega_fwd, dim3(grid), dim3(512), LDS_BYTES, stream, p); }
#endif
}
```

```cpp
#include <hip/hip_runtime.h>
#include <hip/hip_cooperative_groups.h>
#include <cstdio>
#include <cstdint>
namespace cg = cooperative_groups;
namespace pg8 {
#define PG8_LAS __attribute__((address_space(3)))
typedef unsigned short bf16_t;
typedef short bf16x8 __attribute__((ext_vector_type(8)));
typedef float f32x4 __attribute__((ext_vector_type(4)));
typedef unsigned u32x4 __attribute__((ext_vector_type(4)));
constexpr int BM = 256, BK = 64, HALF = 128, HTB = HALF * BK * 2  , STAGE_BYTES = 8 * HTB, NXCD = 8, WGM = 8;

__host__ __device__ __forceinline__ int lds_byte(int r, int c) { const int st = (r >> 4) * 2 + (c >> 5), rr = r & 15, cc = c & 31, ob = rr * 64 + cc * 2; return st * 1024 + (ob ^ (((ob >> 9) & 1) << 5)); }
__host__ __device__ __forceinline__ void stage_rc(int b, int& R, int& C) { const int st = b / 1024, sb = b % 1024, swz = sb ^ (((sb >> 9) & 1) << 5); R = (st >> 1) * 16 + swz / 64; C = (st & 1) * 32 + (swz % 64) / 2; }
__host__ __device__ __forceinline__ int perm32(int rho) { const int n = rho >> 4, i = rho & 15; return 8 * (i >> 2) + 4 * n + (i & 3); }

struct Unit { int pm, pn; };
struct Gemm { const bf16_t* A; const bf16_t* Bt; int M, N, K; };

struct StaticOrder {
    int nM, nN, nwg, G, c;
    __host__ __device__ void init(int M, int N, int G_, int c_) { nM = M / BM; nN = N / BM; nwg = nM * nN; G = G_; c = c_; }
    __host__ __device__ bool next(int i, Unit& u) const {
        const long L = (long)i * G + c; if (L >= nwg) return false;
        int wgid = (int)L; { const int q = nwg / NXCD, r = nwg % NXCD, xcd = wgid % NXCD, off = wgid / NXCD; wgid = (xcd < r ? xcd * (q + 1) : r * (q + 1) + (xcd - r) * q) + off; }
        const int nig = WGM * nN, gid = wgid / nig, fm = gid * WGM, gsz = (nM - fm) < WGM ? (nM - fm) : WGM;
        u.pm = fm + ((wgid % nig) % gsz); u.pn = (wgid % nig) / gsz; return true;
    }
    __device__ __forceinline__ void a_ready(const Unit&) const {}
    __device__ __forceinline__ void done(const Unit&) const {}
};

__device__ __forceinline__ unsigned cvt_pk_bf16(float lo, float hi) { unsigned r; asm volatile("v_cvt_pk_bf16_f32 %0, %1, %2" : "=v"(r) : "v"(lo), "v"(hi)); return r; }
typedef float f32x2 __attribute__((ext_vector_type(2)));
__device__ __forceinline__ float silu_f(float x) { return x * __builtin_amdgcn_rcpf(1.0f + __expf(-x)); }
struct EpiStoreBf16 {
    static constexpr bool PERM = true, AFTER_DRAIN = false;
    bf16_t* O; int ldc;
    __device__ __forceinline__ void operator()(const f32x4 (&acc)[2][2][4][2], const Unit& u, int wr, int wc, int fr, int fq) const {
        const int row0 = u.pm * BM + wr * 64 + fr; const int col0 = u.pn * BM + wc * 32 + 8 * fq;
#pragma unroll
        for (int ai = 0; ai < 2; ++ai)
#pragma unroll
            for (int m = 0; m < 4; ++m) { bf16_t* rowp = O + (size_t)(row0 + ai * HALF + m * 16) * ldc + col0;
#pragma unroll
                for (int bj = 0; bj < 2; ++bj) { const f32x4 v0 = acc[ai][bj][m][0], v1 = acc[ai][bj][m][1];
                    u32x4 w; w.x = cvt_pk_bf16(v0[0], v0[1]); w.y = cvt_pk_bf16(v0[2], v0[3]); w.z = cvt_pk_bf16(v1[0], v1[1]); w.w = cvt_pk_bf16(v1[2], v1[3]);
                    *(u32x4*)(rowp + bj * HALF) = w; } }
    }
};
struct EpiSwiglu {
    static constexpr bool PERM = true, AFTER_DRAIN = false;
    bf16_t* O; int ldc;
    __device__ __forceinline__ void operator()(const f32x4 (&acc)[2][2][4][2], const Unit& u, int wr, int wc, int fr, int fq) const {
        const int row0 = u.pm * BM + wr * 64 + fr; const int col0 = u.pn * HALF + wc * 32 + 8 * fq;
#pragma unroll
        for (int ai = 0; ai < 2; ++ai)
#pragma unroll
            for (int m = 0; m < 4; ++m) { bf16_t* rowp = O + (size_t)(row0 + ai * HALF + m * 16) * ldc + col0;
                const f32x4 g0 = acc[ai][0][m][0], g1 = acc[ai][0][m][1], u0 = acc[ai][1][m][0], u1 = acc[ai][1][m][1];
                f32x4 a, b;
#pragma unroll
                for (int e = 0; e < 4; ++e) { a[e] = silu_f(g0[e]) * u0[e]; b[e] = silu_f(g1[e]) * u1[e]; }
                u32x4 w; w.x = cvt_pk_bf16(a[0], a[1]); w.y = cvt_pk_bf16(a[2], a[3]); w.z = cvt_pk_bf16(b[0], b[1]); w.w = cvt_pk_bf16(b[2], b[3]);
                *(u32x4*)rowp = w; }
    }
};
struct EpiResid {
    static constexpr bool PERM = false, AFTER_DRAIN = false;
    const float* res; float* out; int ldc;
    __device__ __forceinline__ void operator()(const f32x4 (&acc)[2][2][4][2], const Unit& u, int wr, int wc, int fr, int fq) const {
        const int row0 = u.pm * BM + wr * 64 + fr; const int col0 = u.pn * BM + wc * 32 + 4 * fq;
#pragma unroll
        for (int ai = 0; ai < 2; ++ai)
#pragma unroll
            for (int m = 0; m < 4; ++m) { const size_t off = (size_t)(row0 + ai * HALF + m * 16) * ldc + col0;
#pragma unroll
                for (int bj = 0; bj < 2; ++bj)
#pragma unroll
                    for (int n = 0; n < 2; ++n) { const f32x4 r = *(const f32x4*)(res + off + bj * HALF + n * 16); *(f32x4*)(out + off + bj * HALF + n * 16) = r + acc[ai][bj][m][n]; } }
    }
};
template <class Epi, class Sched, bool ALIGN_EPI = false, bool SP2 = false>
__device__ __forceinline__ void gemm_phase(PG8_LAS unsigned char* lds, const Gemm g, const Sched& S, const Epi& E) {
    int tid_ = threadIdx.x; asm volatile("" : "+v"(tid_)); const int tid = tid_, wid = __builtin_amdgcn_readfirstlane(tid >> 6), lane = tid & 63, wr = wid >> 2, wc = wid & 3, fr = lane & 15, fq = lane >> 4;
    const int K = g.K, nt = K / BK;
    unsigned voffA[2], voffB[2];
#pragma unroll
    for (int i = 0; i < 2; ++i) { int R, C; stage_rc(tid * 16 + i * 8192, R, C); const int Rb = Epi::PERM ? ((R & ~31) + perm32(R & 31)) : R;
        voffA[i] = (unsigned)(R * K + C) * 2u; voffB[i] = (unsigned)(Rb * K + C) * 2u; }
    const size_t kstep = (size_t)(BK * 2);
    const size_t hstep = (size_t)HALF * K * 2;
    const size_t tstep = 2 * hstep;
    const unsigned ldsw = (unsigned)wid * 1024u;
    const int aoff = lds_byte(wr * 64 + fr, fq * 8), boff = lds_byte(wc * 32 + fr, fq * 8);
#define PG8_SA(b, h) (((b) * 2 + (h)) * HTB)
#define PG8_SB(b, h) ((4 + (b) * 2 + (h)) * HTB)
#define PG8_STAGE(bufoff, gbase, voff) do { _Pragma("unroll") for (int _i = 0; _i < 2; ++_i) \
        __builtin_amdgcn_global_load_lds((const unsigned*)((const char*)(gbase) + (voff)[_i]), (PG8_LAS unsigned*)(lds + (bufoff) + ldsw + _i * 8192), 16, 0, 0); } while (0)
#define PG8_LDA(dst, b, h) do { _Pragma("unroll") for (int m = 0; m < 4; ++m) _Pragma("unroll") for (int k = 0; k < 2; ++k) dst[m][k] = *(const PG8_LAS bf16x8*)(lds + PG8_SA(b, h) + aoff + m * 2048 + k * 1024); } while (0)
#define PG8_LDB(dst, b, h) do { _Pragma("unroll") for (int n = 0; n < 2; ++n) _Pragma("unroll") for (int k = 0; k < 2; ++k) dst[n][k] = *(const PG8_LAS bf16x8*)(lds + PG8_SB(b, h) + boff + n * 2048 + k * 1024); } while (0)
#define PG8_MMA(ai, bj, At, Bt) do { __builtin_amdgcn_s_setprio(1); _Pragma("unroll") for (int m = 0; m < 4; ++m) _Pragma("unroll") for (int n = 0; n < 2; ++n) _Pragma("unroll") for (int k = 0; k < 2; ++k) \
        acc[ai][bj][m][n] = __builtin_amdgcn_mfma_f32_16x16x32_bf16(Bt[n][k], At[m][k], acc[ai][bj][m][n], 0, 0, 0); __builtin_amdgcn_s_setprio(0); } while (0)
#define PG8_WAIT_V(n) asm volatile("s_waitcnt vmcnt(" #n ")" ::: "memory")
#define PG8_WAIT_L(n) asm volatile("s_waitcnt lgkmcnt(" #n ")" ::: "memory")
#define PG8_BAR __builtin_amdgcn_s_barrier()
#define PG8_SCHED __builtin_amdgcn_sched_barrier(0)
    Unit cur, nxt; int ui = 0;
    if (!S.next(0, cur)) return;
    f32x4 acc[2][2][4][2];
#pragma unroll
    for (int a = 0; a < 2; ++a)
#pragma unroll
        for (int b = 0; b < 2; ++b)
#pragma unroll
            for (int m = 0; m < 4; ++m)
#pragma unroll
                for (int n = 0; n < 2; ++n) acc[a][b][m][n] = (f32x4){0.f, 0.f, 0.f, 0.f};
    bf16x8 At[4][2], B0[2][2], B1[2][2];
    const char* cA = (const char*)g.A + (size_t)cur.pm * tstep; const char* cB = (const char*)g.Bt + (size_t)cur.pn * tstep;
    S.a_ready(cur);
    if constexpr (SP2) {
        PG8_STAGE(PG8_SB(0, 0), cB, voffB); PG8_STAGE(PG8_SB(0, 1), cB + hstep, voffB); PG8_STAGE(PG8_SA(0, 0), cA, voffA); PG8_STAGE(PG8_SA(0, 1), cA + hstep, voffA);
        if (wr == 1) PG8_BAR;
        PG8_WAIT_V(2); PG8_BAR;
        PG8_STAGE(PG8_SB(1, 0), cB + kstep, voffB); PG8_STAGE(PG8_SA(1, 0), cA + kstep, voffA); PG8_STAGE(PG8_SB(1, 1), cB + hstep + kstep, voffB);
        PG8_WAIT_V(6); PG8_BAR;
    } else {
        PG8_STAGE(PG8_SB(0, 0), cB, voffB); PG8_STAGE(PG8_SA(0, 0), cA, voffA); PG8_STAGE(PG8_SB(0, 1), cB + hstep, voffB); PG8_STAGE(PG8_SA(0, 1), cA + hstep, voffA);
        if (wr == 1) PG8_BAR;
        PG8_WAIT_V(4); PG8_BAR;
        PG8_STAGE(PG8_SB(1, 0), cB + kstep, voffB); PG8_STAGE(PG8_SA(1, 0), cA + kstep, voffA); PG8_STAGE(PG8_SB(1, 1), cB + hstep + kstep, voffB);
        PG8_WAIT_V(6); PG8_BAR;
    }
    for (;;) {
        const bool has_next = S.next(ui + 1, nxt);
        const char* nA = has_next ? (const char*)g.A + (size_t)nxt.pm * tstep : cA; const char* nB = has_next ? (const char*)g.Bt + (size_t)nxt.pn * tstep : cB;
        for (int t = 0; t < nt; t += 2) {
            const bool last = (t == nt - 2);
            const char* a1 = cA + (size_t)(t + 1) * kstep;
            const char* a2 = last ? nA : cA + (size_t)(t + 2) * kstep; const char* b2 = last ? nB : cB + (size_t)(t + 2) * kstep;
            const char* a3 = a2 + kstep; const char* b3 = b2 + kstep;
            if (last && has_next) S.a_ready(nxt);
            if constexpr (SP2) {
            PG8_LDB(B0, 0, 0); PG8_LDB(B1, 0, 1); PG8_SCHED; PG8_LDA(At, 0, 0); PG8_STAGE(PG8_SA(1, 1), a1 + hstep, voffA);
            PG8_WAIT_V(8); PG8_WAIT_L(0); PG8_BAR; PG8_MMA(0, 0, At, B0); PG8_MMA(0, 1, At, B1); PG8_BAR; PG8_SCHED;
            PG8_LDA(At, 0, 1); PG8_STAGE(PG8_SB(0, 0), b2, voffB); PG8_STAGE(PG8_SB(0, 1), b2 + hstep, voffB); PG8_STAGE(PG8_SA(0, 0), a2, voffA);
            PG8_WAIT_V(8); PG8_WAIT_L(0); PG8_BAR; PG8_MMA(1, 0, At, B0); PG8_MMA(1, 1, At, B1); PG8_BAR; PG8_SCHED;
            PG8_LDB(B0, 1, 0); PG8_LDB(B1, 1, 1); PG8_SCHED; PG8_LDA(At, 1, 0); PG8_STAGE(PG8_SA(0, 1), a2 + hstep, voffA);
            PG8_WAIT_V(8); PG8_WAIT_L(0); PG8_BAR; PG8_MMA(0, 0, At, B0); PG8_MMA(0, 1, At, B1); PG8_BAR; PG8_SCHED;
            PG8_LDA(At, 1, 1); PG8_STAGE(PG8_SB(1, 0), b3, voffB); PG8_STAGE(PG8_SB(1, 1), b3 + hstep, voffB); PG8_STAGE(PG8_SA(1, 0), a3, voffA);
            PG8_WAIT_V(8); PG8_WAIT_L(0); PG8_BAR; PG8_MMA(1, 0, At, B0); PG8_MMA(1, 1, At, B1); PG8_BAR; PG8_SCHED;
            } else {
            PG8_LDB(B0, 0, 0); PG8_SCHED; PG8_LDA(At, 0, 0); PG8_STAGE(PG8_SA(1, 1), a1 + hstep, voffA);
            PG8_WAIT_L(8); PG8_BAR; PG8_WAIT_L(0); PG8_MMA(0, 0, At, B0); PG8_BAR; PG8_SCHED;
            PG8_LDB(B1, 0, 1); PG8_STAGE(PG8_SB(0, 0), b2, voffB);
            PG8_BAR; PG8_WAIT_L(0); PG8_MMA(0, 1, At, B1); PG8_BAR;
            PG8_LDA(At, 0, 1); PG8_STAGE(PG8_SA(0, 0), a2, voffA);
            PG8_BAR; PG8_WAIT_L(0); PG8_MMA(1, 0, At, B0); PG8_BAR; PG8_SCHED;
            PG8_STAGE(PG8_SB(0, 1), b2 + hstep, voffB);
            PG8_WAIT_V(6); PG8_BAR; PG8_MMA(1, 1, At, B1); PG8_BAR;
            PG8_LDB(B0, 1, 0); PG8_SCHED; PG8_LDA(At, 1, 0); PG8_STAGE(PG8_SA(0, 1), a2 + hstep, voffA);
            PG8_WAIT_L(8); PG8_BAR; PG8_WAIT_L(0); PG8_MMA(0, 0, At, B0); PG8_BAR; PG8_SCHED;
            PG8_LDB(B1, 1, 1); PG8_STAGE(PG8_SB(1, 0), b3, voffB);
            PG8_BAR; PG8_WAIT_L(0); PG8_MMA(0, 1, At, B1); PG8_BAR;
            PG8_LDA(At, 1, 1); PG8_STAGE(PG8_SA(1, 0), a3, voffA);
            PG8_BAR; PG8_WAIT_L(0); PG8_MMA(1, 0, At, B0); PG8_BAR; PG8_SCHED;
            PG8_STAGE(PG8_SB(1, 1), b3 + hstep, voffB);
            PG8_WAIT_V(6); PG8_BAR; PG8_MMA(1, 1, At, B1); PG8_BAR;
            }
        }
        if constexpr (ALIGN_EPI) { if (wr == 0) PG8_BAR; }
        if constexpr (!Epi::AFTER_DRAIN) { E(acc, cur, wr, wc, fr, fq); S.done(cur); }
        if (!has_next) break;
#pragma unroll
        for (int a = 0; a < 2; ++a)
#pragma unroll
            for (int b = 0; b < 2; ++b)
#pragma unroll
                for (int m = 0; m < 4; ++m)
#pragma unroll
                    for (int n = 0; n < 2; ++n) acc[a][b][m][n] = (f32x4){0.f, 0.f, 0.f, 0.f};
        cur = nxt; cA = nA; cB = nB; ++ui;
        if constexpr (ALIGN_EPI) { if (wr == 1) PG8_BAR; }
    }
    PG8_WAIT_V(0);
    if constexpr (!ALIGN_EPI) { if (wr == 0) PG8_BAR; }
    PG8_BAR;
    if constexpr (Epi::AFTER_DRAIN) { E.fused(acc, cur, wr, wc, fr, fq, lds, wid, lane); S.done(cur); }
#undef PG8_SA
#undef PG8_SB
#undef PG8_STAGE
#undef PG8_LDA
#undef PG8_LDB
#undef PG8_MMA
#undef PG8_WAIT_V
#undef PG8_WAIT_L
#undef PG8_BAR
#undef PG8_SCHED
}
}
typedef float f32x2_t __attribute__((ext_vector_type(2)));
#define LAS __attribute__((address_space(3)))
typedef unsigned short bf16;
typedef float f32x4 __attribute__((ext_vector_type(4)));
typedef unsigned u32x4 __attribute__((ext_vector_type(4)));
typedef unsigned u32x2 __attribute__((ext_vector_type(2)));

constexpr int BATCH = 8, SEQ = 2048, DM = 1024, DEPTH = 4, M = BATCH * SEQ;
constexpr int INDIM = 3344, NPROJ = 3328, DFF = 2816, NGU = 2 * DFF, NBQKV = 1536;
constexpr int PC_QA = 0, PC_KA = 256, PC_VA = 512, PC_QB = 768, PC_KB = 1280, PC_VB = 1792, PC_ZB = 2304, PC_QC = 2816, PC_KC = 3072, PC_VC = 3200;
constexpr float EPS = 1e-6f;
constexpr int NPH = 10;
constexpr int LDS_BYTES = 147456;

constexpr size_t WS_CTL = 0;
constexpr size_t WS_G = 65536;
constexpr size_t WS_BETA = WS_G + (size_t)M * 8 * 4;
constexpr size_t WS_WIN = WS_BETA + (size_t)M * 8 * 4;
constexpr size_t WS_WO = WS_WIN + (size_t)NPROJ * DM * 2;
constexpr size_t WS_WGU = WS_WO + (size_t)DM * DM * 2;
constexpr size_t WS_WD = WS_WGU + (size_t)NGU * DM * 2;
constexpr size_t WS_XN = WS_WD + (size_t)DM * DFF * 2;
constexpr size_t WS_PROJ = WS_XN + (size_t)M * DM * 2;
constexpr size_t WS_X1 = WS_PROJ + (size_t)M * NPROJ * 2;
constexpr size_t WS_NW = WS_X1;
constexpr size_t WS_QB = WS_X1 + (size_t)M * 512 * 4;
constexpr size_t WS_KB = WS_QB + (size_t)M * 512 * 2;
constexpr size_t WS_U = WS_XN;
constexpr size_t WS_VB = WS_X1 + (size_t)M * DM * 4;
constexpr size_t WS_MIX = WS_VB + (size_t)M * 512 * 2;
constexpr size_t WS_QKD = WS_MIX + (size_t)M * DM * 2;
constexpr size_t WS_GCL = WS_QKD + (size_t)2048 * 4096 * 2;
constexpr size_t WS_OF = WS_GCL + (size_t)2048 * 64 * 4;
constexpr size_t WS_OB = WS_OF + (size_t)M * 512 * 2;
constexpr size_t WS_VTA = WS_OB + (size_t)M * 512 * 2;
constexpr size_t WS_VTC = WS_VTA + (size_t)M * 256 * 2;
constexpr size_t WS_VT3 = WS_VTC + (size_t)M * 128 * 2;
constexpr size_t WS_END = WS_VT3 + (size_t)M * 256 * 2;

struct Params { const float* in[15]; float* out; unsigned char* ws; int ph_lo, ph_hi; };
enum { I_X = 0, I_NORM1, I_WIN, I_QNA, I_KNA, I_CONV, I_ALOG, I_DTB, I_ONORM, I_QNC, I_KNC, I_WOUT, I_NORM2, I_WGU, I_WD };

__device__ __forceinline__ float bf2f(unsigned v) { return __uint_as_float(v << 16); }
__device__ __forceinline__ float bflo(unsigned v) { return __uint_as_float(v << 16); }
__device__ __forceinline__ float bfhi(unsigned v) { return __uint_as_float(v & 0xffff0000u); }
__device__ __forceinline__ unsigned pk2(float lo, float hi) { unsigned r; asm("v_cvt_pk_bf16_f32 %0, %1, %2" : "=v"(r) : "v"(lo), "v"(hi)); return r; }
__device__ __forceinline__ unsigned f2bf(float f) { return pk2(f, f) & 0xffffu; }
template <int CTRL> __device__ __forceinline__ float dpp_add(float v) { return v + __int_as_float(__builtin_amdgcn_update_dpp(0, __float_as_int(v), CTRL, 0xf, 0xf, true)); }
__device__ __forceinline__ float wave_sum(float v) {
    v = dpp_add<0xB1>(v); v = dpp_add<0x4E>(v); v = dpp_add<0x141>(v); v = dpp_add<0x140>(v);
    { const auto r16 = __builtin_amdgcn_permlane16_swap(__float_as_uint(v), __float_as_uint(v), false, false); v = __uint_as_float(r16[0]) + __uint_as_float(r16[1]); }
    { const auto r32 = __builtin_amdgcn_permlane32_swap(__float_as_uint(v), __float_as_uint(v), false, false); v = __uint_as_float(r32[0]) + __uint_as_float(r32[1]); }
    return v;
}
#define LDS_WAIT() asm volatile("s_waitcnt lgkmcnt(0)" ::: "memory")

struct Ctx { int tid, lane, wave, gw, ngw; LAS unsigned char* lds; };

__device__ __forceinline__ void tr_item(const float* __restrict__ W, int ldw, int K, int src_col0, bf16* WT, int dst_row0, int kb, LAS float* scr, int lane) {
    const int k0 = 64 * kb;
#pragma unroll 8
    for (int i = 0; i < 32; ++i) { const int kk = 2 * i + (lane >> 5); scr[kk * 33 + (lane & 31)] = W[(size_t)(k0 + kk) * ldw + src_col0 + (lane & 31)]; }
    LDS_WAIT();
    const int c = lane & 7;
#pragma unroll
    for (int j = 0; j < 4; ++j) { const int n = (lane >> 3) + 8 * j; const LAS float* s = scr + (8 * c) * 33 + n;
        u32x4 o; o.x = pk2(s[0 * 33], s[1 * 33]); o.y = pk2(s[2 * 33], s[3 * 33]); o.z = pk2(s[4 * 33], s[5 * 33]); o.w = pk2(s[6 * 33], s[7 * 33]);
        *(u32x4*)(WT + (size_t)(dst_row0 + n) * K + k0 + 8 * c) = o; }
    LDS_WAIT();
}

__device__ __forceinline__ void convert_weights(const Params& P, const Ctx& C, int L) {
    LAS float* scr = (LAS float*)(C.lds + C.wave * 16384);
    unsigned char* ws = P.ws;
    const float* win = P.in[I_WIN] + (size_t)L * DM * INDIM;
    const float* wout = P.in[I_WOUT] + (size_t)L * DM * DM;
    const float* wgu = P.in[I_WGU] + (size_t)L * DM * NGU;
    const float* wd = P.in[I_WD] + (size_t)L * DFF * DM;
    constexpr int N_IN = 16 * (NPROJ / 32), N_OUT = 16 * (DM / 32), N_GU = 16 * (NGU / 32), N_D = (DFF / 64) * (DM / 32);
    for (int it = C.gw; it < N_IN + N_OUT + N_GU + N_D; it += C.ngw) {
        int r = it;
        if (r < N_IN) { const int kb = r / (NPROJ / 32), nb = r % (NPROJ / 32), d0 = 32 * nb; tr_item(win, INDIM, DM, d0 < 2816 ? d0 : d0 + 16, (bf16*)(ws + WS_WIN), d0, kb, scr, C.lane); continue; }
        r -= N_IN;
        if (r < N_OUT) { const int kb = r / 32, nb = r % 32; tr_item(wout, DM, DM, 32 * nb, (bf16*)(ws + WS_WO), 32 * nb, kb, scr, C.lane); continue; }
        r -= N_OUT;
        if (r < N_GU) { const int kb = r / (NGU / 32), sb = r % (NGU / 32), j0 = 32 * sb; const int isup = j0 >= DFF, j = isup ? j0 - DFF : j0;
            tr_item(wgu, NGU, DM, j0, (bf16*)(ws + WS_WGU), (j / 128) * 256 + isup * 128 + (j % 128), kb, scr, C.lane); continue; }
        r -= N_GU;
        { const int kb = r / 32, nb = r % 32; tr_item(wd, DM, DFF, 32 * nb, (bf16*)(ws + WS_WD), 32 * nb, kb, scr, C.lane); }
    }
}

template <bool WITH_AB>
__device__ __forceinline__ void norm_rows(const Params& P, const Ctx& C, int L, const float* x, const float* nw) {
    bf16* XN = (bf16*)(P.ws + WS_XN);
    const LAS float* wab = (const LAS float*)C.lds;
    constexpr int RB = 4;
    for (int m0 = C.gw; m0 < M; m0 += RB * C.ngw) {
        f32x4 v[RB][4]; float rs[RB];
#pragma unroll
        for (int j = 0; j < RB; ++j) { const int m = m0 + j * C.ngw < M ? m0 + j * C.ngw : m0; const f32x4* xr = (const f32x4*)(x + (size_t)m * DM) + C.lane;
#pragma unroll
            for (int q = 0; q < 4; ++q) v[j][q] = xr[64 * q]; }
#pragma unroll
        for (int j = 0; j < RB; ++j) { float s = 0.f;
#pragma unroll
            for (int q = 0; q < 4; ++q) s += (v[j][q].x * v[j][q].x + v[j][q].y * v[j][q].y) + (v[j][q].z * v[j][q].z + v[j][q].w * v[j][q].w);
            rs[j] = s; }
#pragma unroll
        for (int j = 0; j < RB; ++j) rs[j] = __builtin_amdgcn_rsqf(wave_sum(rs[j]) * (1.0f / DM) + EPS);
#pragma unroll
        for (int q = 0; q < 4; ++q) { const f32x4 w4 = ((const f32x4*)nw)[C.lane + 64 * q];
#pragma unroll
            for (int j = 0; j < RB; ++j) v[j][q] = v[j][q] * rs[j] * w4; }
#pragma unroll
        for (int j = 0; j < RB; ++j) { const int m = m0 + j * C.ngw; if (m < M) { u32x2* o8 = (u32x2*)(XN + (size_t)m * DM) + C.lane;
#pragma unroll
            for (int q = 0; q < 4; ++q) { u32x2 o; o.x = pk2(v[j][q].x, v[j][q].y); o.y = pk2(v[j][q].z, v[j][q].w); o8[64 * q] = o; } } }
        if constexpr (WITH_AB) {
            float mine[RB];
#pragma unroll
            for (int j = 0; j < RB; ++j) mine[j] = 0.f;
#pragma unroll 2
            for (int c = 0; c < 16; ++c) {
                f32x2_t a2[RB];
#pragma unroll
                for (int j = 0; j < RB; ++j) a2[j] = (f32x2_t){0.f, 0.f};
#pragma unroll
                for (int q = 0; q < 4; ++q) { const f32x4 w4 = *(const LAS f32x4*)(wab + c * 1024 + 4 * C.lane + 256 * q);
#pragma unroll
                    for (int j = 0; j < RB; ++j) { a2[j] += (f32x2_t){v[j][q].x, v[j][q].y} * (f32x2_t){w4.x, w4.y}; a2[j] += (f32x2_t){v[j][q].z, v[j][q].w} * (f32x2_t){w4.z, w4.w}; } }
#pragma unroll
                for (int j = 0; j < RB; ++j) { const float a = wave_sum(a2[j].x + a2[j].y); if (C.lane == c) mine[j] = a; }
            }
#pragma unroll
            for (int j = 0; j < RB; ++j) { const int m = m0 + j * C.ngw; if (m < M) {
                if (C.lane < 8) {
                    const float al = P.in[I_ALOG][L * 8 + C.lane], dtb = P.in[I_DTB][L * 8 + C.lane];
                    const float xx = mine[j] + dtb; const float sp = xx > 20.f ? xx : log1pf(expf(xx));
                    ((float*)(P.ws + WS_G))[(size_t)m * 8 + C.lane] = -expf(al) * sp;
                } else if (C.lane < 16) {
                    ((float*)(P.ws + WS_BETA))[(size_t)m * 8 + C.lane - 8] = 1.0f / (1.0f + expf(-mine[j]));
                } } }
        }
    }
}

__device__ __forceinline__ void phase_n1(const Params& P, const Ctx& C, int L) {
    convert_weights(P, C, L);
    __syncthreads();
    {
        const float* win = P.in[I_WIN] + (size_t)L * DM * INDIM + 2816;
        LAS float* wab = (LAS float*)C.lds;
        for (int e = C.tid; e < 16 * 1024; e += 512) { const int k = e >> 4, c = e & 15; wab[c * 1024 + k] = win[(size_t)k * INDIM + c]; }
    }
    __syncthreads();
    const float* x = L == 0 ? P.in[I_X] : P.out;
    norm_rows<true>(P, C, L, x, P.in[I_NORM1] + L * DM);
    __syncthreads();
}

__device__ __forceinline__ void phase_prep(const Params& P, const Ctx& C, int L) {
    bf16* PROJ = (bf16*)(P.ws + WS_PROJ);
    bf16* QB = (bf16*)(P.ws + WS_QB); bf16* KB = (bf16*)(P.ws + WS_KB); bf16* VB = (bf16*)(P.ws + WS_VB);
    const int lane = C.lane;
    const float qna = P.in[I_QNA][L * 64 + lane], kna = P.in[I_KNA][L * 64 + lane], qnc = P.in[I_QNC][L * 64 + lane], knc = P.in[I_KNC][L * 64 + lane];
    const float invA = exp2f(-(float)(lane & 7) * (1.0f / 8.0f) * 18.931568569324174f);
    const float invC = exp2f(-(float)(lane & 15) * (1.0f / 16.0f) * 13.287712379549449f);
    const float* cw = P.in[I_CONV] + (size_t)L * 5 * NBQKV;
    for (int tb = C.gw; tb < M / 8; tb += C.ngw) {
      const int tokb = tb * 8, tbt = tokb & (SEQ - 1);
#pragma unroll 1
      for (int jb = 0; jb < 8; jb += 4) {
        unsigned xa4[4][8], xc4[4][6];
#pragma unroll
        for (int jj = 0; jj < 4; ++jj) { const bf16* prl = PROJ + (size_t)(tokb + jb + jj) * NPROJ;
#pragma unroll
            for (int v = 0; v < 8; ++v) xa4[jj][v] = prl[(v < 4 ? PC_QA : PC_KA) + (v & 3) * 64 + lane];
#pragma unroll
            for (int v = 0; v < 6; ++v) xc4[jj][v] = prl[(v < 4 ? PC_QC + v * 64 : PC_KC + (v - 4) * 64) + lane]; }
#pragma unroll
       for (int jj = 0; jj < 4; ++jj) {
        const int j = jb + jj;
        const int tok = tokb + j, t = tbt + j;
        bf16* pr = PROJ + (size_t)tok * NPROJ;
        unsigned xa[8], xc[6];
#pragma unroll
        for (int v = 0; v < 8; ++v) xa[v] = xa4[jj][v];
#pragma unroll
        for (int v = 0; v < 6; ++v) xc[v] = xc4[jj][v];
        float sA, cA;
        { float rev = (float)t * invA * 0.15915494309189535f; rev -= floorf(rev); sA = __builtin_amdgcn_sinf(rev); cA = __builtin_amdgcn_cosf(rev); }
        float ssa[8];
#pragma unroll
        for (int v = 0; v < 8; ++v) { const float x = bf2f(xa[v]); ssa[v] = wave_sum(x * x); }
#pragma unroll
        for (int v = 0; v < 8; ++v) {
            float y = bf2f(xa[v]) * (__builtin_amdgcn_rsqf(ssa[v] * (1.0f / 64.0f) + EPS)) * (v < 4 ? qna : kna);
            const float pa = __int_as_float(__builtin_amdgcn_update_dpp(0, __float_as_int(y), 0x128, 0xf, 0xf, true));
            if (lane < 8) y = y * cA - pa * sA; else if (lane < 16) y = y * cA + pa * sA;
            if (v < 4) y *= 0.18033688011112042f;
            pr[(v < 4 ? PC_QA : PC_KA) + (v & 3) * 64 + lane] = (bf16)f2bf(y);
        }
        float sC, cC;
        { const float pos = lane < 32 ? (float)(t >> 6) : (float)(t & 63); float rev = pos * invC * 0.15915494309189535f; rev -= floorf(rev); sC = __builtin_amdgcn_sinf(rev); cC = __builtin_amdgcn_cosf(rev); }
        float ssc[6];
#pragma unroll
        for (int v = 0; v < 6; ++v) { const float x = bf2f(xc[v]); ssc[v] = wave_sum(x * x); }
#pragma unroll
        for (int v = 0; v < 6; ++v) {
            float y = bf2f(xc[v]) * (__builtin_amdgcn_rsqf(ssc[v] * (1.0f / 64.0f) + EPS)) * (v < 4 ? qnc : knc);
            const float pa = __shfl_xor(y, 16);
            if ((lane & 16) == 0) y = y * cC - pa * sC; else y = y * cC + pa * sC;
            if (v < 4) y *= 0.18033688011112042f;
            pr[(v < 4 ? PC_QC + v * 64 : PC_KC + (v - 4) * 64) + lane] = (bf16)f2bf(y);
        }
       }
      }
#pragma unroll 1
      for (int part = 0; part < 3; ++part) {
        const bf16* src = PROJ + PC_QB + part * 512 + 2 * lane;
        f32x2_t w2[4][5]; unsigned rows[12][4];
#pragma unroll
        for (int h = 0; h < 4; ++h)
#pragma unroll
            for (int d = 0; d < 5; ++d) w2[h][d] = *(const f32x2_t*)(cw + d * NBQKV + part * 512 + h * 128 + 2 * lane);
#pragma unroll
        for (int rr = 0; rr < 12; ++rr) { const int tt = tbt + rr - 2;
#pragma unroll
            for (int h = 0; h < 4; ++h) rows[rr][h] = (tt >= 0 && tt < SEQ) ? *(const unsigned*)(src + (size_t)(tokb + rr - 2) * NPROJ + h * 128) : 0u; }
        bf16* dst = (part == 0 ? QB : (part == 1 ? KB : VB)) + 2 * lane;
#pragma unroll
        for (int j = 0; j < 8; ++j) {
            float a0[4], a1[4], ss[4];
#pragma unroll
            for (int h = 0; h < 4; ++h) { f32x2_t xx = (f32x2_t){0.f, 0.f};
#pragma unroll
                for (int d = 0; d < 5; ++d) xx += w2[h][d] * (f32x2_t){bflo(rows[j + d][h]), bfhi(rows[j + d][h])};
                const float x0 = xx.x, x1 = xx.y;
                a0[h] = x0 * __builtin_amdgcn_rcpf(1.0f + __expf(-x0)); a1[h] = x1 * __builtin_amdgcn_rcpf(1.0f + __expf(-x1)); ss[h] = a0[h] * a0[h] + a1[h] * a1[h]; }
            if (part < 2) {
#pragma unroll
                for (int h = 0; h < 4; ++h) ss[h] = wave_sum(ss[h]);
#pragma unroll
                for (int h = 0; h < 4; ++h) { float sc = __builtin_amdgcn_rsqf(ss[h] + EPS); if (part == 0) sc *= 0.08838834764831845f; a0[h] *= sc; a1[h] *= sc; } }
#pragma unroll
            for (int h = 0; h < 4; ++h) *(unsigned*)(dst + (size_t)(tokb + j) * 512 + h * 128) = pk2(a0[h], a1[h]);
        }
      }
    }
    {   LAS bf16* scr = (LAS bf16*)(C.lds + C.wave * 16384);
        for (int it = C.gw; it < BATCH * 6 * 32 + BATCH * 4 * 16 * 2; it += C.ngw) {
            const bf16* src; bf16* dst; size_t rstep = NPROJ, dstep = SEQ;
            if (it < BATCH * 6 * 32) { const int b = it / 192, hs = (it / 32) % 6, tb = it & 31;
                src = PROJ + ((size_t)b * SEQ + tb * 64) * NPROJ + (hs < 4 ? PC_VA + 64 * hs : PC_VC + 64 * (hs - 4)) + lane;
                dst = (hs < 4 ? (bf16*)(P.ws + WS_VTA) + ((size_t)(b * 4 + hs) * 64) * SEQ : (bf16*)(P.ws + WS_VTC) + ((size_t)(b * 2 + hs - 4) * 64) * SEQ) + tb * 64 + lane;
            } else { const int idx = it - BATCH * 6 * 32, b = idx >> 7, h = (idx >> 5) & 3, rr = (idx >> 1) & 15, half = idx & 1;
                src = PROJ + ((size_t)b * SEQ + rr + 16 * 64 * half) * NPROJ + PC_VA + 64 * h + lane; rstep = (size_t)16 * NPROJ;
                dst = (bf16*)(P.ws + WS_VT3) + ((size_t)((b * 4 + h) * 16 + rr) * 64) * 128 + half * 64 + lane; dstep = 128; }
#pragma unroll 8
            for (int i = 0; i < 64; ++i) scr[i * 66 + lane] = src[(size_t)i * rstep];
            LDS_WAIT();
#pragma unroll 8
            for (int d = 0; d < 64; ++d) dst[(size_t)d * dstep] = scr[lane * 66 + d];
            LDS_WAIT(); }
    }
}

#define LDS_BARRIER() do { asm volatile("s_waitcnt lgkmcnt(0)" ::: "memory"); __builtin_amdgcn_s_barrier(); asm volatile("" ::: "memory"); } while (0)
typedef short bf16x8_t __attribute__((ext_vector_type(8)));
typedef float f32x16_t __attribute__((ext_vector_type(16)));
typedef short s16x4_t __attribute__((ext_vector_type(4)));
__device__ __forceinline__ unsigned cvtpk(float lo, float hi) { unsigned r; asm volatile("v_cvt_pk_bf16_f32 %0, %1, %2" : "=v"(r) : "v"(lo), "v"(hi)); return r; }
template <int R0, int NR> __device__ __forceinline__ void b1_rows(f32x2_t (&sol)[32], const LAS float* Ar) {
#pragma unroll
    for (int ip = (R0 < 1 ? 1 : R0); ip < R0 + NR; ++ip) { f32x2_t a01 = (f32x2_t){0.f, 0.f}, a23 = (f32x2_t){0.f, 0.f};
#pragma unroll
        for (int j4 = 0; j4 < (ip + 3) / 4; ++j4) { const f32x4 a4 = *(const LAS f32x4*)(Ar + ip * 64 + 4 * j4);
            a01 -= (f32x2_t){a4.x, a4.y} * sol[2 * j4]; a23 -= (f32x2_t){a4.z, a4.w} * sol[2 * j4 + 1]; }
        const f32x2_t a = a01 + a23;
        sol[ip >> 1][ip & 1] += a.x + a.y; }
}
__device__ __forceinline__ void b1_item(const Params& P, const Ctx& C, int item) {
    const int b = item >> 7, c = (item >> 2) & 31, h = item & 3;
    int tid_ = C.tid; asm volatile("" : "+v"(tid_)); const int tid = tid_, lane = tid_ & 63;
    LAS unsigned char* L = C.lds;
    LAS unsigned char* Ks = L; LAS unsigned char* Qs = L + 17408;
    LAS float* KKf = (LAS float*)(L + 34816); LAS float* QKf = (LAS float*)(L + 51456);
    LAS float* gcl = (LAS float*)(L + 68096); LAS float* bel = gcl + 128;
    LAS float* Ad = (LAS float*)(L + 69120);
    const bf16* QB = (const bf16*)(P.ws + WS_QB); const bf16* KB = (const bf16*)(P.ws + WS_KB); const bf16* VB = (const bf16*)(P.ws + WS_VB);
    const float* G = (const float*)(P.ws + WS_G); const float* BETA = (const float*)(P.ws + WS_BETA);
    const size_t tok0 = (size_t)b * SEQ + c * 64;
#pragma unroll
    for (int m = 0; m < 2; ++m) { const int e = tid + 512 * m, r = e >> 4, p = e & 15;
        *(LAS u32x4*)(Ks + r * 272 + p * 16) = *(const u32x4*)(KB + (tok0 + r) * 512 + h * 128 + p * 8);
        *(LAS u32x4*)(Qs + r * 272 + p * 16) = *(const u32x4*)(QB + (tok0 + r) * 512 + h * 128 + p * 8); }
    u32x4 vpre[2];
#pragma unroll
    for (int m = 0; m < 2; ++m) { const int e = tid + 512 * m, r = e >> 4, p = e & 15; vpre[m] = *(const u32x4*)(VB + (tok0 + r) * 512 + h * 128 + p * 8); }
    if (tid < 128) { const int dir = tid >> 6, i = dir ? 63 - lane : lane; const size_t tok = tok0 + i;
        float g = G[tok * 8 + dir * 4 + h];
#pragma unroll
        for (int o = 1; o < 64; o <<= 1) { const float t = __shfl_up(g, o); if (lane >= o) g += t; }
        gcl[dir * 64 + lane] = g; bel[dir * 64 + lane] = BETA[tok * 8 + dir * 4 + h]; }
    LDS_BARRIER();
    { const int prod = C.wave >> 2, ti = (C.wave >> 1) & 1, tj = C.wave & 1, r = lane & 31, hh = lane >> 5;
      f32x16_t acc;
#pragma unroll
      for (int e = 0; e < 16; ++e) acc[e] = 0.f;
      const LAS unsigned char* Ab = (prod ? Qs : Ks) + (32 * ti + r) * 272 + hh * 16; const LAS unsigned char* Bb = Ks + (32 * tj + r) * 272 + hh * 16;
#pragma unroll
      for (int ks = 0; ks < 8; ++ks) { const bf16x8_t a = *(const LAS bf16x8_t*)(Ab + ks * 32), bb = *(const LAS bf16x8_t*)(Bb + ks * 32); acc = __builtin_amdgcn_mfma_f32_32x32x16_bf16(a, bb, acc, 0, 0, 0); }
      LAS float* dst = prod ? QKf : KKf;
#pragma unroll
      for (int e = 0; e < 16; ++e) dst[(32 * ti + (e & 3) + 8 * (e >> 2) + 4 * hh) * 65 + 32 * tj + r] = acc[e]; }
    LDS_BARRIER();
#pragma unroll
    for (int m = 0; m < 2; ++m) { const int e = tid + 512 * m, r = e >> 4, p = e & 15; *(LAS u32x4*)(Qs + r * 272 + p * 16) = vpre[m]; }
    const int dir = C.wave >> 2, t = tid & 255;
    const int cs = (dir ? 31 - c : c) * 64 + ((b * 4 + h) * 2 + dir);
    { bf16* qkd = (bf16*)(P.ws + WS_QKD) + (size_t)cs * 4096;
#pragma unroll
      for (int n = 0; n < 8; ++n) { const int e = 2 * (t + 256 * n), ip = e >> 6, jp = e & 63, i = dir ? 63 - ip : ip; float qv[2];
#pragma unroll
          for (int c2 = 0; c2 < 2; ++c2) { const int jq = jp + c2, j = dir ? 63 - jq : jq;
              const float dec = jq <= ip ? __expf(gcl[dir * 64 + ip] - gcl[dir * 64 + jq]) : 0.f;
              Ad[dir * 4096 + ip * 64 + jq] = jq < ip ? bel[dir * 64 + ip] * KKf[i * 65 + j] * dec : 0.f;
              qv[c2] = QKf[i * 65 + j] * dec; }
          *(unsigned*)(qkd + ip * 64 + jp) = pk2(qv[0], qv[1]); }
      if (t < 64) ((float*)(P.ws + WS_GCL))[(size_t)cs * 64 + t] = gcl[dir * 64 + t]; }
    LDS_BARRIER();
    { f32x2_t sol[32];
      const LAS float* gd = gcl + dir * 64; const LAS float* bd = bel + dir * 64;
      const int rstep = dir ? -272 : 272;
      if (t < 128) { const LAS unsigned char* vp = Qs + (dir ? 63 * 272 : 0) + t * 2;
#pragma unroll
          for (int ip = 0; ip < 64; ++ip) sol[ip >> 1][ip & 1] = bf2f(*(const LAS bf16*)(vp + ip * rstep)) * bd[ip];
      } else { const LAS unsigned char* kp = Ks + (dir ? 63 * 272 : 0) + (t - 128) * 2;
#pragma unroll
          for (int ip = 0; ip < 64; ++ip) sol[ip >> 1][ip & 1] = bf2f(*(const LAS bf16*)(kp + ip * rstep)) * bd[ip] * __expf(gd[ip]);
      }
      const LAS float* Ar = Ad + dir * 4096;
#pragma unroll 1
      for (int rb = 0; rb < 24; ++rb) {
          switch (rb) {
          case 0: b1_rows<0, 4>(sol, Ar); break;
          case 1: b1_rows<4, 4>(sol, Ar); break;
          case 2: b1_rows<8, 4>(sol, Ar); break;
          case 3: b1_rows<12, 4>(sol, Ar); break;
          case 4: b1_rows<16, 4>(sol, Ar); break;
          case 5: b1_rows<20, 4>(sol, Ar); break;
          case 6: b1_rows<24, 4>(sol, Ar); break;
          case 7: b1_rows<28, 4>(sol, Ar); break;
          case 8: b1_rows<32, 2>(sol, Ar); break;
          case 9: b1_rows<34, 2>(sol, Ar); break;
          case 10: b1_rows<36, 2>(sol, Ar); break;
          case 11: b1_rows<38, 2>(sol, Ar); break;
          case 12: b1_rows<40, 2>(sol, Ar); break;
          case 13: b1_rows<42, 2>(sol, Ar); break;
          case 14: b1_rows<44, 2>(sol, Ar); break;
          case 15: b1_rows<46, 2>(sol, Ar); break;
          case 16: b1_rows<48, 2>(sol, Ar); break;
          case 17: b1_rows<50, 2>(sol, Ar); break;
          case 18: b1_rows<52, 2>(sol, Ar); break;
          case 19: b1_rows<54, 2>(sol, Ar); break;
          case 20: b1_rows<56, 2>(sol, Ar); break;
          case 21: b1_rows<58, 2>(sol, Ar); break;
          case 22: b1_rows<60, 2>(sol, Ar); break;
          case 23: b1_rows<62, 2>(sol, Ar); break;
          default: break; }
      }
      LDS_BARRIER();
      LAS unsigned char* img = L + 34816 + dir * 32768;
      const float sg = t < 128 ? 1.f : -1.f;
#pragma unroll
      for (int ip = 0; ip < 64; ++ip) *(LAS bf16*)(img + ip * 512 + t * 2) = (bf16)f2bf(sg * sol[ip >> 1][ip & 1]); }
    LDS_BARRIER();
    { const LAS unsigned char* img = L + 34816 + dir * 32768;
      bf16* Ud = (bf16*)(P.ws + WS_U) + (size_t)cs * 8192; bf16* Nd = (bf16*)(P.ws + WS_NW) + (size_t)cs * 8192;
#pragma unroll
      for (int m = 0; m < 8; ++m) { const int e = t + 256 * m, row = e >> 5, p = e & 31; const u32x4 w = *(const LAS u32x4*)(img + row * 512 + p * 16);
          *(u32x4*)((p < 16 ? Ud : Nd) + row * 128 + (p & 15) * 8) = w; } }
    LDS_BARRIER();
}

constexpr int B2_NW = 0, B2_QG = 17408, B2_QK = 34816, B2_KGT = 44032, B2_EGL = 62464, B2_BUF = 62976;
struct B2Regs { u32x4 nw[2], qk, qv[2], kv[2]; float gq[2], gk, glast; };
__device__ __forceinline__ void b2_load(const Params& P, int chain, int n, int tid_, B2Regs& R) {
    int tid = tid_; asm volatile("" : "+v"(tid));
    const int b = chain >> 3, h = (chain >> 1) & 3, dir = chain & 1, cs = n * 64 + chain, c = dir ? 31 - n : n;
    const size_t tok0 = (size_t)b * SEQ + c * 64;
    const float* gcl = (const float*)(P.ws + WS_GCL) + (size_t)cs * 64;
    const bf16* NWg = (const bf16*)(P.ws + WS_NW) + (size_t)cs * 8192; const bf16* QKg = (const bf16*)(P.ws + WS_QKD) + (size_t)cs * 4096;
    const bf16* QB = (const bf16*)(P.ws + WS_QB); const bf16* KB = (const bf16*)(P.ws + WS_KB);
#pragma unroll
    for (int m = 0; m < 2; ++m) R.nw[m] = *(const u32x4*)(NWg + (tid + 512 * m) * 8);
    R.qk = *(const u32x4*)(QKg + tid * 8);
#pragma unroll
    for (int m = 0; m < 2; ++m) { const int e = tid + 512 * m, ip = e >> 4, p = e & 15, i = dir ? 63 - ip : ip; R.qv[m] = *(const u32x4*)(QB + (tok0 + i) * 512 + h * 128 + p * 8); R.gq[m] = gcl[ip]; }
#pragma unroll
    for (int m = 0; m < 2; ++m) { const int e = tid + 512 * m, ip = e & 63, p = e >> 6, i = dir ? 63 - ip : ip; R.kv[m] = *(const u32x4*)(KB + (tok0 + i) * 512 + h * 128 + p * 8); }
    R.gk = gcl[tid & 63]; R.glast = gcl[63];
}
__device__ __forceinline__ void b2_write(const B2Regs& R, LAS unsigned char* buf, int tid_) {
    int tid = tid_; asm volatile("" : "+v"(tid));
#pragma unroll
    for (int m = 0; m < 2; ++m) { const int e = tid + 512 * m, r = e >> 4, p = e & 15; *(LAS u32x4*)(buf + B2_NW + r * 272 + p * 16) = R.nw[m]; }
    { const int r = tid >> 3, p = tid & 7; *(LAS u32x4*)(buf + B2_QK + r * 144 + p * 16) = R.qk; }
#pragma unroll
    for (int m = 0; m < 2; ++m) { const int e = tid + 512 * m, ip = e >> 4, p = e & 15; const u32x4 q = R.qv[m]; const float s = __expf(R.gq[m]);
        u32x4 o; o.x = cvtpk(bflo(q.x) * s, bfhi(q.x) * s); o.y = cvtpk(bflo(q.y) * s, bfhi(q.y) * s); o.z = cvtpk(bflo(q.z) * s, bfhi(q.z) * s); o.w = cvtpk(bflo(q.w) * s, bfhi(q.w) * s);
        *(LAS u32x4*)(buf + B2_QG + ip * 272 + p * 16) = o; }
    const float sk = __expf(R.glast - R.gk);
#pragma unroll
    for (int m = 0; m < 2; ++m) { const int e = tid + 512 * m, ip = e & 63, p = e >> 6; const u32x4 k = R.kv[m];
        LAS bf16* d = (LAS bf16*)(buf + B2_KGT) + (8 * p) * 72 + ip;
        d[0] = (bf16)f2bf(bflo(k.x) * sk); d[72] = (bf16)f2bf(bfhi(k.x) * sk); d[144] = (bf16)f2bf(bflo(k.y) * sk); d[216] = (bf16)f2bf(bfhi(k.y) * sk);
        d[288] = (bf16)f2bf(bflo(k.z) * sk); d[360] = (bf16)f2bf(bfhi(k.z) * sk); d[432] = (bf16)f2bf(bflo(k.w) * sk); d[504] = (bf16)f2bf(bfhi(k.w) * sk); }
    if (tid == 0) *(LAS float*)(buf + B2_EGL) = __expf(R.glast);
}
__device__ __forceinline__ bf16x8_t ldA(const LAS unsigned char* p) {
    const s16x4_t lo = *(const LAS s16x4_t*)p, hi = *(const LAS s16x4_t*)(p + 32);
    return (bf16x8_t){lo[0], lo[1], lo[2], lo[3], hi[0], hi[1], hi[2], hi[3]};
}
__device__ __forceinline__ bf16x8_t packB(const f32x4& a, const f32x4& b) {
    u32x4 w; w.x = cvtpk(a[0], a[1]); w.y = cvtpk(a[2], a[3]); w.z = cvtpk(b[0], b[1]); w.w = cvtpk(b[2], b[3]);
    return __builtin_bit_cast(bf16x8_t, w);
}
#define B2_PIPE(N) do { __builtin_amdgcn_sched_group_barrier(0x100, 4, 0); _Pragma("unroll") for (int i_ = 0; i_ < (N) - 4; ++i_) { __builtin_amdgcn_sched_group_barrier(0x008, 1, 0); __builtin_amdgcn_sched_group_barrier(0x100, 1, 0); } \
    __builtin_amdgcn_sched_group_barrier(0x008, 4, 0); } while (0)

template <int O0, int O1, int O2, int O3, int O4, int O5, int O6, int O7>
__device__ __forceinline__ void rd8(s16x4_t (&d)[8], unsigned base) {
    asm volatile("ds_read_b64 %0, %8 offset:%9\n\tds_read_b64 %1, %8 offset:%10\n\tds_read_b64 %2, %8 offset:%11\n\tds_read_b64 %3, %8 offset:%12\n\t"
                 "ds_read_b64 %4, %8 offset:%13\n\tds_read_b64 %5, %8 offset:%14\n\tds_read_b64 %6, %8 offset:%15\n\tds_read_b64 %7, %8 offset:%16"
                 : "=&v"(d[0]), "=&v"(d[1]), "=&v"(d[2]), "=&v"(d[3]), "=&v"(d[4]), "=&v"(d[5]), "=&v"(d[6]), "=&v"(d[7])
                 : "v"(base), "n"(O0), "n"(O1), "n"(O2), "n"(O3), "n"(O4), "n"(O5), "n"(O6), "n"(O7) : "memory");
}
struct Frag8 { s16x4_t lo[8], hi[8]; };
template <int OFF, int STEP_T, int KS2> __device__ __forceinline__ void frag_issue(Frag8& f, unsigned base) {
    rd8<OFF, OFF + STEP_T, OFF + 2 * STEP_T, OFF + 3 * STEP_T, OFF + KS2, OFF + KS2 + STEP_T, OFF + KS2 + 2 * STEP_T, OFF + KS2 + 3 * STEP_T>(f.lo, base);
    rd8<OFF + 32, OFF + STEP_T + 32, OFF + 2 * STEP_T + 32, OFF + 3 * STEP_T + 32, OFF + KS2 + 32, OFF + KS2 + STEP_T + 32, OFF + KS2 + 2 * STEP_T + 32, OFF + KS2 + 3 * STEP_T + 32>(f.hi, base);
}
__device__ __forceinline__ void frag_wait(Frag8& f) {
    asm volatile("s_waitcnt lgkmcnt(0)" : "+v"(f.lo[0]), "+v"(f.lo[1]), "+v"(f.lo[2]), "+v"(f.lo[3]), "+v"(f.lo[4]), "+v"(f.lo[5]), "+v"(f.lo[6]), "+v"(f.lo[7]) :: "memory");
    asm volatile("s_waitcnt lgkmcnt(0)" : "+v"(f.hi[0]), "+v"(f.hi[1]), "+v"(f.hi[2]), "+v"(f.hi[3]), "+v"(f.hi[4]), "+v"(f.hi[5]), "+v"(f.hi[6]), "+v"(f.hi[7]) :: "memory");
}
__device__ __forceinline__ bf16x8_t frag_get(const Frag8& f, int i) { return (bf16x8_t){f.lo[i][0], f.lo[i][1], f.lo[i][2], f.lo[i][3], f.hi[i][0], f.hi[i][1], f.hi[i][2], f.hi[i][3]}; }
template <int OFF, int STRIDE, int T0, int KS> __device__ __forceinline__ void b2_rd4(bf16x8_t (&A)[8], int slot, const LAS unsigned char* const (&q)[4]) {
#pragma unroll
    for (int t = 0; t < 4; ++t) { const int o = OFF + (16 * (T0 + t)) * STRIDE + 64 * (KS & ~1);
        const s16x4_t lo = *(const LAS s16x4_t*)(q[2 * (KS & 1)] + o), hi = *(const LAS s16x4_t*)(q[2 * (KS & 1) + 1] + o);
        A[slot + t] = (bf16x8_t){lo[0], lo[1], lo[2], lo[3], hi[0], hi[1], hi[2], hi[3]}; }
}
__device__ __forceinline__ void b2_step(LAS unsigned char* buf, f32x4 (&S)[8], const u32x4 (&uq)[2], LAS unsigned char* scr, bf16* Orow, int lane, int g, int l15) {
    *(LAS u32x4*)(scr + lane * 32) = uq[0]; *(LAS u32x4*)(scr + lane * 32 + 16) = uq[1];
    LDS_WAIT();
    unsigned short ur[4][4];
#pragma unroll
    for (int t = 0; t < 4; ++t)
#pragma unroll
        for (int r = 0; r < 4; ++r) ur[t][r] = *(const LAS bf16*)(scr + (16 * t + 4 * g + r) * 32 + l15 * 2);
    const LAS unsigned char* b272[4]; const LAS unsigned char* b144[4];
#pragma unroll
    for (int i = 0; i < 4; ++i) { b272[i] = buf + l15 * 272 + g * 8 + 32 * i; b144[i] = buf + l15 * 144 + g * 8 + 32 * i; asm volatile("" : "+v"(b272[i]), "+v"(b144[i])); }
    bf16x8_t A0[8], A1[8];
    b2_rd4<B2_NW, 272, 0, 0>(A0, 0, b272); b2_rd4<B2_NW, 272, 0, 1>(A0, 4, b272);
    f32x4 vn[4];
#pragma unroll
    for (int t = 0; t < 4; ++t)
#pragma unroll
        for (int r = 0; r < 4; ++r) vn[t][r] = bf2f(ur[t][r]);
    bf16x8_t Sb[4];
#pragma unroll
    for (int ks = 0; ks < 4; ++ks) Sb[ks] = packB(S[2 * ks], S[2 * ks + 1]);
    __builtin_amdgcn_sched_barrier(0);
    b2_rd4<B2_NW, 272, 0, 2>(A1, 0, b272); b2_rd4<B2_NW, 272, 0, 3>(A1, 4, b272);
#pragma unroll
    for (int i = 0; i < 8; ++i) vn[i & 3] = __builtin_amdgcn_mfma_f32_16x16x32_bf16(A0[i], Sb[i >> 2], vn[i & 3], 0, 0, 0);
    __builtin_amdgcn_sched_barrier(0);
    b2_rd4<B2_QG, 272, 0, 0>(A0, 0, b272); b2_rd4<B2_QG, 272, 0, 1>(A0, 4, b272);
#pragma unroll
    for (int i = 0; i < 8; ++i) vn[i & 3] = __builtin_amdgcn_mfma_f32_16x16x32_bf16(A1[i], Sb[2 + (i >> 2)], vn[i & 3], 0, 0, 0);
    __builtin_amdgcn_sched_barrier(0);
    bf16x8_t vb[2];
#pragma unroll
    for (int ks = 0; ks < 2; ++ks) vb[ks] = packB(vn[2 * ks], vn[2 * ks + 1]);
    f32x4 o[4];
#pragma unroll
    for (int t = 0; t < 4; ++t) o[t] = (f32x4){0.f, 0.f, 0.f, 0.f};
    b2_rd4<B2_QG, 272, 0, 2>(A1, 0, b272); b2_rd4<B2_QG, 272, 0, 3>(A1, 4, b272);
#pragma unroll
    for (int i = 0; i < 8; ++i) o[i & 3] = __builtin_amdgcn_mfma_f32_16x16x32_bf16(A0[i], Sb[i >> 2], o[i & 3], 0, 0, 0);
    __builtin_amdgcn_sched_barrier(0);
    b2_rd4<B2_QK, 144, 0, 0>(A0, 0, b144); b2_rd4<B2_QK, 144, 0, 1>(A0, 4, b144);
#pragma unroll
    for (int i = 0; i < 8; ++i) o[i & 3] = __builtin_amdgcn_mfma_f32_16x16x32_bf16(A1[i], Sb[2 + (i >> 2)], o[i & 3], 0, 0, 0);
    __builtin_amdgcn_sched_barrier(0);
    b2_rd4<B2_KGT, 144, 0, 0>(A1, 0, b144); b2_rd4<B2_KGT, 144, 4, 0>(A1, 4, b144);
#pragma unroll
    for (int i = 0; i < 8; ++i) o[i & 3] = __builtin_amdgcn_mfma_f32_16x16x32_bf16(A0[i], vb[i >> 2], o[i & 3], 0, 0, 0);
    __builtin_amdgcn_sched_barrier(0);
#pragma unroll
    for (int t = 0; t < 4; ++t)
#pragma unroll
        for (int r = 0; r < 4; ++r) *(LAS bf16*)(scr + (16 * t + 4 * g + r) * 32 + l15 * 2) = (bf16)f2bf(o[t][r]);
    LDS_WAIT();
    { const u32x4 w0 = *(const LAS u32x4*)(scr + lane * 32), w1 = *(const LAS u32x4*)(scr + lane * 32 + 16); *(u32x4*)Orow = w0; *(u32x4*)(Orow + 8) = w1; }
    const float egl = *(const LAS float*)(buf + B2_EGL);
#pragma unroll
    for (int t = 0; t < 8; ++t) S[t] = S[t] * egl;
    b2_rd4<B2_KGT, 144, 0, 1>(A0, 0, b144); b2_rd4<B2_KGT, 144, 4, 1>(A0, 4, b144);
#pragma unroll
    for (int i = 0; i < 8; ++i) S[i] = __builtin_amdgcn_mfma_f32_16x16x32_bf16(A1[i], vb[0], S[i], 0, 0, 0);
    __builtin_amdgcn_sched_barrier(0);
#pragma unroll
    for (int i = 0; i < 8; ++i) S[i] = __builtin_amdgcn_mfma_f32_16x16x32_bf16(A0[i], vb[1], S[i], 0, 0, 0);
}
__device__ __forceinline__ void b2_uload(const bf16* Urow, u32x4 (&uq)[2]) { uq[0] = *(const u32x4*)Urow; uq[1] = *(const u32x4*)(Urow + 8); }
__device__ __forceinline__ void b2_chain(const Params& P, const Ctx& C, int chain) {
    const int b = chain >> 3, h = (chain >> 1) & 3, dir = chain & 1;
    int tid_ = C.tid; asm volatile("" : "+v"(tid_)); const int tid = tid_, lane = tid & 63, g = lane >> 4, l15 = lane & 15;
    LAS unsigned char* base = C.lds;
    const int v0 = 16 * C.wave;
    const bf16* Ug = (const bf16*)(P.ws + WS_U) + (size_t)chain * 8192 + lane * 128 + v0;
    bf16* OUT = (bf16*)(P.ws + (dir ? WS_OB : WS_OF)) + (size_t)b * SEQ * 512 + (dir ? 63 - lane : lane) * 512 + h * 128 + v0;
    LAS unsigned char* scr = base + 2 * B2_BUF + C.wave * 2048;
    B2Regs R0, R1;
    u32x4 u0[2], u1[2];
    f32x4 S[8];
#pragma unroll
    for (int t = 0; t < 8; ++t) S[t] = (f32x4){0.f, 0.f, 0.f, 0.f};
    b2_load(P, chain, 0, tid, R0); b2_uload(Ug, u0);
    b2_load(P, chain, 1, tid, R1); b2_uload(Ug + (size_t)64 * 8192, u1);
    b2_write(R0, base, tid);
    LDS_BARRIER();
    for (int n = 0; n < 32; n += 2) {
        if (n + 2 < 32) b2_load(P, chain, n + 2, tid, R0);
        { const int c = dir ? 31 - n : n; b2_step(base, S, u0, scr, OUT + (size_t)c * 64 * 512, lane, g, l15); }
        if (n + 2 < 32) b2_uload(Ug + (size_t)(n + 2) * 64 * 8192, u0);
        b2_write(R1, base + B2_BUF, tid);
        LDS_BARRIER();
        if (n + 3 < 32) b2_load(P, chain, n + 3, tid, R1);
        { const int c = dir ? 31 - (n + 1) : n + 1; b2_step(base + B2_BUF, S, u1, scr, OUT + (size_t)c * 64 * 512, lane, g, l15); }
        if (n + 3 < 32) b2_uload(Ug + (size_t)(n + 3) * 64 * 8192, u1);
        if (n + 2 < 32) b2_write(R0, base, tid);
        LDS_BARRIER();
    }
}

constexpr int AT_K = 0, AT_V = 9216, AT_BUF = 18432, AT_ITEM = 40960;
template <int MODE>
__device__ __forceinline__ void attn_item(const Params& P, const Ctx& C, int item) {
    constexpr bool IS_A = MODE == 1;
    int tid_ = C.tid; asm volatile("" : "+v"(tid_)); const int tid = tid_, lane = tid & 63, r = lane & 31, hh = lane >> 5; const int wave = C.wave;
    LAS unsigned char* L = C.lds;
    const bf16* PROJ = (const bf16*)(P.ws + WS_PROJ); bf16* MIX = (bf16*)(P.ws + WS_MIX);
    int b, tw, qcol, kcol, vcol, ocol, kt_lo, kt_hi, hA = 0, rres = 0; const bf16* VT;
    if (MODE == 1) { b = item >> 5; const int h = (item >> 3) & 3, q0 = (item & 7) * 256; hA = h; VT = (const bf16*)(P.ws + WS_VTA) + ((size_t)(b * 4 + h) * 64) * SEQ; tw = q0 + 32 * wave; qcol = PC_QA + 64 * h; kcol = PC_KA + 64 * h; vcol = PC_VA + 64 * h; ocol = 64 * h;
        kt_lo = q0 - 256 < 0 ? 0 : (q0 - 256) >> 6; kt_hi = ((q0 + 511) >> 6) + 1; if (kt_hi > 32) kt_hi = 32; }
    else if (MODE == 2) { b = item >> 6; const int h = (item >> 4) & 3; hA = h; rres = item & 15; VT = (const bf16*)(P.ws + WS_VT3) + ((size_t)((b * 4 + h) * 16 + rres) * 64) * 128; tw = 32 * (wave & 3); qcol = PC_QA + 64 * h; kcol = PC_KA + 64 * h; vcol = 0; ocol = 0;
        kt_lo = 0; kt_hi = 2; }
    else { b = item >> 5; const int kvh = (item >> 4) & 1, q0 = (item & 15) * 128, qh = kvh * 2 + (wave >> 2); VT = (const bf16*)(P.ws + WS_VTC) + ((size_t)(b * 2 + kvh) * 64) * SEQ; tw = q0 + 32 * (wave & 3); qcol = PC_QC + 64 * qh; kcol = PC_KC + 64 * kvh; vcol = PC_VC + 64 * kvh; ocol = 768 + 64 * qh;
        kt_lo = 0; kt_hi = 32; }
    const size_t tokb = (size_t)b * SEQ;
    const int q = tw + r;
    bf16x8_t qf[4];
    const size_t qtok = tokb + (MODE == 2 ? rres + 16 * q : q);
#pragma unroll
    for (int s4 = 0; s4 < 4; ++s4) qf[s4] = *(const bf16x8_t*)(PROJ + qtok * NPROJ + qcol + 16 * s4 + 8 * hh);
    unsigned mask16 = 0u, mask4 = 0u;
    if (IS_A) {
#pragma unroll
        for (int e = 0; e < 16; ++e) { const int kr = (e & 3) + 8 * (e >> 2) + 4 * hh; const int d = kr - q;
            if ((d & 15) == 0) mask16 |= (1u << e) | (1u << (16 + e)); if ((d & 3) == 0) mask4 |= (1u << e) | (1u << (16 + e)); }
    }
    const int kkey = tid >> 3, kp = tid & 7;
    constexpr size_t KSTEP = (MODE == 2 ? 16 : 1) * (size_t)64 * NPROJ;
    const bf16* ksrc = PROJ + (tokb + (MODE == 2 ? rres + 16 * kkey : kkey)) * NPROJ + kcol + 8 * kp; const bf16* vsrc = VT + (size_t)kkey * (MODE == 2 ? 128 : SEQ) + 8 * kp;
    const int kdst = AT_K + kkey * 144 + kp * 16, vdst = AT_V + kkey * 144 + kp * 16;
    u32x4 kreg = *(const u32x4*)(ksrc + (size_t)kt_lo * KSTEP), vreg = *(const u32x4*)(vsrc + kt_lo * 64);
#define AT_WRITE(bufo) do { *(LAS u32x4*)(L + (bufo) + kdst) = kreg; *(LAS u32x4*)(L + (bufo) + vdst) = vreg; } while (0)
    AT_WRITE(0);
    f32x16_t o0, o1;
#pragma unroll
    for (int e = 0; e < 16; ++e) { o0[e] = 0.f; o1[e] = 0.f; }
    float m = -INFINITY, l = 0.f;
    float* part = (float*)((unsigned char*)(P.ws + WS_PROJ) + qtok * (size_t)(NPROJ * 2) + PC_QB * 2) + hA * 68;
    if (MODE == 1) { m = part[64]; l = hh == 0 ? part[65] : 0.f;
#pragma unroll
        for (int g4 = 0; g4 < 4; ++g4) { const f32x4 a = *(const f32x4*)(part + 8 * g4 + 4 * hh), c4 = *(const f32x4*)(part + 32 + 8 * g4 + 4 * hh);
#pragma unroll
            for (int e = 0; e < 4; ++e) { o0[4 * g4 + e] = a[e]; o1[4 * g4 + e] = c4[e]; } } }
    __syncthreads();
    for (int kt = kt_lo; kt < kt_hi; ++kt) {
        const int cur = ((kt - kt_lo) & 1) * AT_BUF;
        if (kt + 1 < kt_hi) { kreg = *(const u32x4*)(ksrc + (size_t)(kt + 1) * KSTEP); vreg = *(const u32x4*)(vsrc + (kt + 1) * 64); }
        const int k0 = kt * 64;
        const int dlo = k0 - (tw + 31), dhi = k0 + 63 - tw;
        const int dmin = dlo > 0 ? dlo : (dhi < 0 ? -dhi : 0), dmax = -dlo > dhi ? -dlo : dhi;
        if ((MODE != 1 || dmin <= 256) && !(MODE == 2 && wave >= 4)) {
            f32x16_t s0, s1;
#pragma unroll
            for (int e = 0; e < 16; ++e) { s0[e] = 0.f; s1[e] = 0.f; }
            const LAS unsigned char* kb = L + cur + AT_K + r * 144 + hh * 16;
#pragma unroll
            for (int s4 = 0; s4 < 4; ++s4) { const bf16x8_t a0 = *(const LAS bf16x8_t*)(kb + s4 * 32), a1 = *(const LAS bf16x8_t*)(kb + 32 * 144 + s4 * 32);
                s0 = __builtin_amdgcn_mfma_f32_32x32x16_bf16(a0, qf[s4], s0, 0, 0, 0); s1 = __builtin_amdgcn_mfma_f32_32x32x16_bf16(a1, qf[s4], s1, 0, 0, 0); }
            float w0[16], w1[16];
            if (IS_A) {
#pragma unroll
                for (int e = 0; e < 16; ++e) { const int kr = (e & 3) + 8 * (e >> 2) + 4 * hh;
                    { const int d = k0 + kr - q, ad = d < 0 ? -d : d; w0[e] = (ad <= 64 ? 1.f : 0.f) + (((mask4 >> e) & 1u) && ad <= 256 ? 1.f : 0.f); }
                    { const int d = k0 + 32 + kr - q, ad = d < 0 ? -d : d; w1[e] = (ad <= 64 ? 1.f : 0.f) + (((mask4 >> e) & 1u) && ad <= 256 ? 1.f : 0.f); } }
#pragma unroll
                for (int e = 0; e < 16; ++e) { if (w0[e] == 0.f) s0[e] = -INFINITY; if (w1[e] == 0.f) s1[e] = -INFINITY; }
            }
            if (MODE == 2 && dmax > 64) {
#pragma unroll
                for (int e = 0; e < 16; ++e) { const int kr = (e & 3) + 8 * (e >> 2) + 4 * hh;
                    { const int d = k0 + kr - q, ad = d < 0 ? -d : d; if (ad > 64) s0[e] = -INFINITY; }
                    { const int d = k0 + 32 + kr - q, ad = d < 0 ? -d : d; if (ad > 64) s1[e] = -INFINITY; } }
            }
            float mx = fmaxf(s0[0], s1[0]);
#pragma unroll
            for (int e = 1; e < 16; ++e) mx = fmaxf(mx, fmaxf(s0[e], s1[e]));
            mx = fmaxf(mx, __shfl_xor(mx, 32));
            const float mn = fmaxf(m, mx), mu = mn == -INFINITY ? 0.f : mn;
            const float alpha = __builtin_amdgcn_exp2f(m - mu);
            float ps = 0.f;
#pragma unroll
            for (int e = 0; e < 16; ++e) { float p0 = __builtin_amdgcn_exp2f(s0[e] - mu), p1 = __builtin_amdgcn_exp2f(s1[e] - mu); if (IS_A) { p0 *= w0[e]; p1 *= w1[e]; } s0[e] = p0; s1[e] = p1; ps += p0 + p1; }
            l = l * alpha + ps; m = mn;
#pragma unroll
            for (int e = 0; e < 16; ++e) { o0[e] *= alpha; o1[e] *= alpha; }
            bf16x8_t pb[2][2];
#pragma unroll
            for (int s2 = 0; s2 < 2; ++s2) {
                u32x4 w; w.x = cvtpk(s0[8 * s2], s0[8 * s2 + 1]); w.y = cvtpk(s0[8 * s2 + 2], s0[8 * s2 + 3]); w.z = cvtpk(s0[8 * s2 + 4], s0[8 * s2 + 5]); w.w = cvtpk(s0[8 * s2 + 6], s0[8 * s2 + 7]); pb[0][s2] = __builtin_bit_cast(bf16x8_t, w);
                w.x = cvtpk(s1[8 * s2], s1[8 * s2 + 1]); w.y = cvtpk(s1[8 * s2 + 2], s1[8 * s2 + 3]); w.z = cvtpk(s1[8 * s2 + 4], s1[8 * s2 + 5]); w.w = cvtpk(s1[8 * s2 + 6], s1[8 * s2 + 7]); pb[1][s2] = __builtin_bit_cast(bf16x8_t, w); }
            const LAS unsigned char* vq[8];
#pragma unroll
            for (int i = 0; i < 8; ++i) { vq[i] = L + cur + AT_V + r * 144 + hh * 8 + 16 * i; asm volatile("" : "+v"(vq[i])); }
#pragma unroll
            for (int u = 0; u < 2; ++u)
#pragma unroll
                for (int s2 = 0; s2 < 2; ++s2) { const int ki = 2 * (2 * u + s2);
                    const s16x4_t lo0 = *(const LAS s16x4_t*)(vq[ki]), hi0 = *(const LAS s16x4_t*)(vq[ki + 1]), lo1 = *(const LAS s16x4_t*)(vq[ki] + 32 * 144), hi1 = *(const LAS s16x4_t*)(vq[ki + 1] + 32 * 144);
                    const bf16x8_t a0 = (bf16x8_t){lo0[0], lo0[1], lo0[2], lo0[3], hi0[0], hi0[1], hi0[2], hi0[3]}, a1 = (bf16x8_t){lo1[0], lo1[1], lo1[2], lo1[3], hi1[0], hi1[1], hi1[2], hi1[3]};
                    o0 = __builtin_amdgcn_mfma_f32_32x32x16_bf16(a0, pb[u][s2], o0, 0, 0, 0); o1 = __builtin_amdgcn_mfma_f32_32x32x16_bf16(a1, pb[u][s2], o1, 0, 0, 0); }
        }
        if (kt + 1 < kt_hi) AT_WRITE(cur ^ AT_BUF);
        __syncthreads();
    }
#undef AT_WRITE
    const float lt = l + __shfl_xor(l, 32);
    if (MODE == 2) {
        if (wave < 4) {
#pragma unroll
            for (int g4 = 0; g4 < 4; ++g4) { *(f32x4*)(part + 8 * g4 + 4 * hh) = (f32x4){o0[4 * g4], o0[4 * g4 + 1], o0[4 * g4 + 2], o0[4 * g4 + 3]};
                *(f32x4*)(part + 32 + 8 * g4 + 4 * hh) = (f32x4){o1[4 * g4], o1[4 * g4 + 1], o1[4 * g4 + 2], o1[4 * g4 + 3]}; }
            if (hh == 0) { part[64] = m; part[65] = lt; } }
        return; }
    const float inv = __builtin_amdgcn_rcpf(lt);
    bf16* op = MIX + (tokb + q) * 1024 + ocol + 4 * hh;
#pragma unroll
    for (int g4 = 0; g4 < 4; ++g4) { u32x2 w; w.x = cvtpk(o0[4 * g4] * inv, o0[4 * g4 + 1] * inv); w.y = cvtpk(o0[4 * g4 + 2] * inv, o0[4 * g4 + 3] * inv); *(u32x2*)(op + 8 * g4) = w;
        w.x = cvtpk(o1[4 * g4] * inv, o1[4 * g4 + 1] * inv); w.y = cvtpk(o1[4 * g4 + 2] * inv, o1[4 * g4 + 3] * inv); *(u32x2*)(op + 32 + 8 * g4) = w; }
}
__device__ __forceinline__ void phase_b1(const Params& P, const Ctx& C, int L) {
    for (int item = blockIdx.x; item < 1024; item += gridDim.x) b1_item(P, C, item);
    for (int it = blockIdx.x; it < 512; it += gridDim.x) attn_item<2>(P, C, it);
}
__device__ __forceinline__ void phase_mix(const Params& P, const Ctx& C, int L, int rep) {
    unsigned* ctr = (unsigned*)(P.ws + WS_CTL) + 64 * L + 16 * rep;
    for (int chain = blockIdx.x; chain < 64; chain += gridDim.x) b2_chain(P, C, chain);
#if SPLIT_MX
    cg::this_grid().sync();
#endif
    for (;;) {
        if (C.tid == 0) *(LAS unsigned*)(C.lds + AT_ITEM) = atomicAdd(ctr, 1u);
        __syncthreads();
        const unsigned it = __builtin_amdgcn_readfirstlane(*(const LAS unsigned*)(C.lds + AT_ITEM));
        __syncthreads();
        if (it >= 512u) break;
        if (it < 256u) attn_item<1>(P, C, (int)it);
        else attn_item<0>(P, C, (int)it - 256);
    }
}

__device__ __forceinline__ void phase_finish(const Params& P, const Ctx& C, int L) {
    const bf16* OF = (const bf16*)(P.ws + WS_OF); const bf16* OB = (const bf16*)(P.ws + WS_OB); const bf16* PROJ = (const bf16*)(P.ws + WS_PROJ); bf16* MIX = (bf16*)(P.ws + WS_MIX);
    const f32x2_t on = *(const f32x2_t*)(P.in[I_ONORM] + L * 128 + 2 * C.lane);
    constexpr int FB = 8;
    for (int it0 = C.gw; it0 < M * 4; it0 += FB * C.ngw) {
        unsigned a[FB], bb[FB], zu[FB];
#pragma unroll
        for (int j = 0; j < FB; ++j) { const int it = it0 + j * C.ngw < M * 4 ? it0 + j * C.ngw : it0; const size_t tok = it >> 2; const int h = it & 3;
            a[j] = *(const unsigned*)(OF + tok * 512 + h * 128 + 2 * C.lane); bb[j] = *(const unsigned*)(OB + tok * 512 + h * 128 + 2 * C.lane); zu[j] = *(const unsigned*)(PROJ + tok * NPROJ + PC_ZB + h * 128 + 2 * C.lane); }
        float o0[FB], o1[FB], ss[FB];
#pragma unroll
        for (int j = 0; j < FB; ++j) { o0[j] = bflo(a[j]) + bflo(bb[j]); o1[j] = bfhi(a[j]) + bfhi(bb[j]); ss[j] = o0[j] * o0[j] + o1[j] * o1[j]; }
#pragma unroll
        for (int j = 0; j < FB; ++j) ss[j] = wave_sum(ss[j]);
#pragma unroll
        for (int j = 0; j < FB; ++j) { const int it = it0 + j * C.ngw; if (it < M * 4) { const size_t tok = it >> 2; const int h = it & 3;
            const float rs = __builtin_amdgcn_rsqf(ss[j] * (1.0f / 128.0f) + EPS); const float z0 = bflo(zu[j]), z1 = bfhi(zu[j]);
            *(unsigned*)(MIX + tok * 1024 + 256 + h * 128 + 2 * C.lane) = pk2(o0[j] * rs * on.x * z0 * __builtin_amdgcn_rcpf(1.0f + __expf(-z0)), o1[j] * rs * on.y * z1 * __builtin_amdgcn_rcpf(1.0f + __expf(-z1))); } }
    }
}

#ifndef SIMPLE_A
#define SIMPLE_A 0
#endif
#ifndef SPLIT_MX
#define SPLIT_MX 0
#endif
#ifndef REP
#define REP 0
#endif
#ifndef SKIP
#define SKIP 0
#endif
#define XB_TMO      128
#define XB_XCNT(j)  (256  + 64 * (j))
#define XB_XSUB(j)  (1280 + 64 * (j))
#define XB_XGEN(j)  (2304 + 64 * (j))
#define XB_TOP      3328
#define XB_TOPGEN   3392
#define XCD_BAR_WORDS 3456
#define XB_SPIN_CAP (1u << 18)

__device__ __forceinline__ unsigned xb_ld(unsigned* p)              { return __hip_atomic_load(p, __ATOMIC_RELAXED, __HIP_MEMORY_SCOPE_AGENT); }
__device__ __forceinline__ unsigned xb_add(unsigned* p, unsigned v) { return __hip_atomic_fetch_add(p, v, __ATOMIC_RELAXED, __HIP_MEMORY_SCOPE_AGENT); }
__device__ __forceinline__ unsigned xb_xcc_id() { return (unsigned)__builtin_amdgcn_s_getreg((3 << 11) | 20) & 0xFu; }
#define XB_SPIN(cond, bar) do { unsigned _sp = 0; while (cond) { __builtin_amdgcn_s_sleep(1); \
    if ((++_sp & 255u) == 0u) { if (xb_ld(&(bar)[XB_TMO])) break; if (_sp > XB_SPIN_CAP) { atomicAdd(&(bar)[XB_TMO], 1u); break; } } } } while (0)

struct XcdBarrier {
    unsigned* bar; unsigned x;
    volatile LAS unsigned* st;
};

__device__ __forceinline__ XcdBarrier xcd_barrier_post(unsigned* bar, volatile LAS unsigned* st) {
    XcdBarrier b; b.bar = bar; b.x = xb_xcc_id(); b.st = st;
    if (threadIdx.x == 0) (void)xb_add(&bar[XB_XCNT(b.x)], 1u);
    return b;
}
__device__ __forceinline__ void xcd_barrier_complete(unsigned* bar, unsigned x, unsigned& nloc, unsigned& nx) {
    const unsigned G = gridDim.x * gridDim.y * gridDim.z;
    unsigned sum, cnt, mine, sp = 0u;
    for (;;) {
        sum = 0u; cnt = 0u; mine = 0u;
#pragma unroll
        for (unsigned j = 0; j < 16; ++j) { const unsigned c = xb_ld(&bar[XB_XCNT(j)]); sum += c; cnt += (c > 0u) ? 1u : 0u; mine = (j == x) ? c : mine; }
        if (sum == G) break;
        __builtin_amdgcn_s_sleep(1);
        if ((++sp & 255u) == 0u) { if (xb_ld(&bar[XB_TMO])) break; if (sp > XB_SPIN_CAP) { atomicAdd(&bar[XB_TMO], 1u); break; } }
    }
    nloc = mine > 0u ? mine : 1u; nx = cnt > 0u ? cnt : 1u;
}

__device__ __forceinline__ void xcd_barrier(const XcdBarrier& b) {
    asm volatile("s_waitcnt vmcnt(0)" ::: "memory");
    __syncthreads();
    if (threadIdx.x == 0) {
        unsigned* bar = b.bar;
        __builtin_amdgcn_s_waitcnt(0);
        unsigned nloc = b.st[0], nx = b.st[1];
        if (nloc == 0u) { xcd_barrier_complete(bar, b.x, nloc, nx); b.st[0] = nloc; b.st[1] = nx; }
        const unsigned old = xb_add(&bar[XB_XSUB(b.x)], 1u);
        const unsigned gen = old / nloc;
        if (old + 1u == (gen + 1u) * nloc) {
            __builtin_amdgcn_fence(__ATOMIC_RELEASE, "agent");
            asm volatile("s_waitcnt vmcnt(0)" ::: "memory");
            const unsigned og = xb_add(&bar[XB_TOP], 1u);
            const unsigned tg = og / nx;
            if (og + 1u == (tg + 1u) * nx) xb_add(&bar[XB_TOPGEN], 1u);
            else XB_SPIN(xb_ld(&bar[XB_TOPGEN]) == tg, bar);
            __builtin_amdgcn_fence(__ATOMIC_ACQUIRE, "agent");
            xb_add(&bar[XB_XGEN(b.x)], 1u);
            asm volatile("s_waitcnt vmcnt(0)" ::: "memory");
        } else {
            XB_SPIN(xb_ld(&bar[XB_XGEN(b.x)]) == gen, bar);
            __builtin_amdgcn_fence(__ATOMIC_ACQUIRE, "agent");
            asm volatile("s_waitcnt vmcnt(0)" ::: "memory");
        }
    }
    __syncthreads();
}

__global__ void __launch_bounds__(512, 2) mega_fwd(Params P) {
    extern __shared__ __attribute__((aligned(16))) unsigned char lds[];
    cg::grid_group grid = cg::this_grid();
    { volatile LAS unsigned* st0 = (volatile LAS unsigned*)((LAS unsigned char*)lds + 147392); if (threadIdx.x < 2) st0[threadIdx.x] = 0u; }
    __syncthreads();
    XcdBarrier xbar = xcd_barrier_post((unsigned*)(P.ws + WS_CTL + 8192), (volatile LAS unsigned*)((LAS unsigned char*)lds + 147392));
    for (int ph = P.ph_lo; ph < P.ph_hi; ++ph) {
        const int L = ph / NPH, p = ph % NPH;
        const int nrep = ((REP >> p) & 1) ? 2 : 1;
        for (int rep = 0; rep < nrep; ++rep) {
        if (rep) xcd_barrier(xbar);
        int tid_ = threadIdx.x; asm volatile("" : "+v"(tid_));
        Ctx C; C.tid = tid_; C.lane = C.tid & 63; C.wave = __builtin_amdgcn_readfirstlane(C.tid >> 6); C.gw = blockIdx.x * 8 + C.wave; C.ngw = gridDim.x * 8; C.lds = (LAS unsigned char*)lds;
        unsigned char* ws = P.ws;
        if (p == 0) { if (!(SKIP & 1)) phase_n1(P, C, L); }
        else if (p == 1) { pg8::Gemm g{(const pg8::bf16_t*)(ws + WS_XN), (const pg8::bf16_t*)(ws + WS_WIN), M, NPROJ, DM}; pg8::StaticOrder S; S.init(M, NPROJ, gridDim.x, blockIdx.x);
            pg8::EpiStoreBf16 E{(pg8::bf16_t*)(ws + WS_PROJ), NPROJ}; pg8::gemm_phase<pg8::EpiStoreBf16, pg8::StaticOrder, true, true>(C.lds, g, S, E); }
        else if (p == 2) { if (!(SKIP & 2)) phase_prep(P, C, L); }
        else if (p == 3) { if (!(SKIP & 16)) phase_b1(P, C, L); }
        else if (p == 4) { if (!(SKIP & 4)) phase_mix(P, C, L, rep); }
        else if (p == 5) { if (!(SKIP & 8)) phase_finish(P, C, L); }
        else if (p == 6) { pg8::Gemm g{(const pg8::bf16_t*)(ws + WS_MIX), (const pg8::bf16_t*)(ws + WS_WO), M, DM, DM}; pg8::StaticOrder S; S.init(M, DM, gridDim.x, blockIdx.x);
            pg8::EpiResid E{L == 0 ? P.in[I_X] : P.out, (float*)(ws + WS_X1), DM}; pg8::gemm_phase<pg8::EpiResid, pg8::StaticOrder, true, true>(C.lds, g, S, E); }
        else if (p == 7) norm_rows<false>(P, C, L, (const float*)(ws + WS_X1), P.in[I_NORM2] + L * DM);
        else if (p == 8) { pg8::Gemm g{(const pg8::bf16_t*)(ws + WS_XN), (const pg8::bf16_t*)(ws + WS_WGU), M, NGU, DM}; pg8::StaticOrder S; S.init(M, NGU, gridDim.x, blockIdx.x);
            pg8::EpiSwiglu E{(pg8::bf16_t*)(ws + WS_PROJ), DFF}; pg8::gemm_phase<pg8::EpiSwiglu, pg8::StaticOrder, true, true>(C.lds, g, S, E); }
        else { pg8::Gemm g{(const pg8::bf16_t*)(ws + WS_PROJ), (const pg8::bf16_t*)(ws + WS_WD), M, DM, DFF}; pg8::StaticOrder S; S.init(M, DM, gridDim.x, blockIdx.x);
            pg8::EpiResid E{(const float*)(ws + WS_X1), P.out, DM}; pg8::gemm_phase<pg8::EpiResid, pg8::StaticOrder, true, true>(C.lds, g, S, E); }
        }
        if (ph + 1 < P.ph_hi) { if (ph == P.ph_lo) grid.sync(); else xcd_barrier(xbar); }
    }
}

#ifndef ONE_LAUNCH
#define ONE_LAUNCH 1
#endif
extern "C" void kernel_launch(void* const* d_in, const int* in_sizes, int n_in, void* d_out, int out_size, void* d_ws, size_t ws_size, hipStream_t stream) {
    static int grid = 0;
    if (!grid) {
        if (n_in != 15 || ws_size < WS_END) { fprintf(stderr, "kernel_launch: unexpected n_in %d / ws_size %zu (need %zu)\n", n_in, ws_size, (size_t)WS_END); return; }
        int dev = 0, cus = 0, per_cu = 0;
        hipGetDevice(&dev); hipDeviceGetAttribute(&cus, hipDeviceAttributeMultiprocessorCount, dev);
        hipFuncSetAttribute((const void*)mega_fwd, hipFuncAttributeMaxDynamicSharedMemorySize, LDS_BYTES);
        hipOccupancyMaxActiveBlocksPerMultiprocessor(&per_cu, mega_fwd, 512, LDS_BYTES);
        if (per_cu < 1) { fprintf(stderr, "kernel_launch: occupancy query says %d blocks per CU\n", per_cu); per_cu = 1; }
        grid = cus * per_cu;
    }
    Params p{};
    for (int i = 0; i < 15; ++i) p.in[i] = (const float*)d_in[i];
    p.out = (float*)d_out; p.ws = (unsigned char*)d_ws;
    hipMemsetAsync((char*)d_ws + WS_CTL, 0, 32768, stream);
#if ONE_LAUNCH
    p.ph_lo = 0; p.ph_hi = DEPTH * NPH;
    void* args[] = {&p};
    hipError_t e = hipLaunchCooperativeKernel((const void*)mega_fwd, dim3(grid), dim3(512), args, LDS_BYTES, stream);
    if (e != hipSuccess) fprintf(stderr, "cooperative launch failed: %s (grid %d)\n", hipGetErrorString(e), grid);
#else
    for (int ph = 0; ph < DEPTH * NPH; ++ph) { p.ph_lo = ph; p.ph_hi = ph + 1; hipLaunchKernelGGL(mega_fwd, dim3(grid), dim3(512), LDS_BYTES, stream, p); }
#endif
}
```

```cpp
#include <hip/hip_runtime.h>
#include <hip/hip_cooperative_groups.h>
#include <cstdio>
#include <cstdint>
namespace cg = cooperative_groups;
namespace pg8 {
#define PG8_LAS __attribute__((address_space(3)))
typedef unsigned short bf16_t;
typedef short bf16x8 __attribute__((ext_vector_type(8)));
typedef float f32x4 __attribute__((ext_vector_type(4)));
typedef unsigned u32x4 __attribute__((ext_vector_type(4)));
constexpr int BM = 256, BK = 64, HALF = 128, HTB = HALF * BK * 2  , STAGE_BYTES = 8 * HTB, NXCD = 8, WGM = 8;

__host__ __device__ __forceinline__ int lds_byte(int r, int c) { const int st = (r >> 4) * 2 + (c >> 5), rr = r & 15, cc = c & 31, ob = rr * 64 + cc * 2; return st * 1024 + (ob ^ (((ob >> 9) & 1) << 5)); }
__host__ __device__ __forceinline__ void stage_rc(int b, int& R, int& C) { const int st = b / 1024, sb = b % 1024, swz = sb ^ (((sb >> 9) & 1) << 5); R = (st >> 1) * 16 + swz / 64; C = (st & 1) * 32 + (swz % 64) / 2; }
__host__ __device__ __forceinline__ int perm32(int rho) { const int n = rho >> 4, i = rho & 15; return 8 * (i >> 2) + 4 * n + (i & 3); }

struct Unit { int pm, pn; };
struct Gemm { const bf16_t* A; const bf16_t* Bt; int M, N, K; };

struct StaticOrder {
    int nM, nN, nwg, G, c;
    __host__ __device__ void init(int M, int N, int G_, int c_) { nM = M / BM; nN = N / BM; nwg = nM * nN; G = G_; c = c_; }
    __host__ __device__ bool next(int i, Unit& u) const {
        const long L = (long)i * G + c; if (L >= nwg) return false;
        int wgid = (int)L; { const int q = nwg / NXCD, r = nwg % NXCD, xcd = wgid % NXCD, off = wgid / NXCD; wgid = (xcd < r ? xcd * (q + 1) : r * (q + 1) + (xcd - r) * q) + off; }
        const int nig = WGM * nN, gid = wgid / nig, fm = gid * WGM, gsz = (nM - fm) < WGM ? (nM - fm) : WGM;
        u.pm = fm + ((wgid % nig) % gsz); u.pn = (wgid % nig) / gsz; return true;
    }
    __device__ __forceinline__ void a_ready(const Unit&) const {}
    __device__ __forceinline__ void done(const Unit&) const {}
};

__device__ __forceinline__ unsigned cvt_pk_bf16(float lo, float hi) { unsigned r; asm volatile("v_cvt_pk_bf16_f32 %0, %1, %2" : "=v"(r) : "v"(lo), "v"(hi)); return r; }
typedef float f32x2 __attribute__((ext_vector_type(2)));
__device__ __forceinline__ float silu_f(float x) { return x * __builtin_amdgcn_rcpf(1.0f + __expf(-x)); }
struct EpiStoreBf16 {
    static constexpr bool PERM = true, AFTER_DRAIN = false;
    bf16_t* O; int ldc;
    __device__ __forceinline__ void operator()(const f32x4 (&acc)[2][2][4][2], const Unit& u, int wr, int wc, int fr, int fq) const {
        const int row0 = u.pm * BM + wr * 64 + fr; const int col0 = u.pn * BM + wc * 32 + 8 * fq;
#pragma unroll
        for (int ai = 0; ai < 2; ++ai)
#pragma unroll
            for (int m = 0; m < 4; ++m) { bf16_t* rowp = O + (size_t)(row0 + ai * HALF + m * 16) * ldc + col0;
#pragma unroll
                for (int bj = 0; bj < 2; ++bj) { const f32x4 v0 = acc[ai][bj][m][0], v1 = acc[ai][bj][m][1];
                    u32x4 w; w.x = cvt_pk_bf16(v0[0], v0[1]); w.y = cvt_pk_bf16(v0[2], v0[3]); w.z = cvt_pk_bf16(v1[0], v1[1]); w.w = cvt_pk_bf16(v1[2], v1[3]);
                    *(u32x4*)(rowp + bj * HALF) = w; } }
    }
};
struct EpiSwiglu {
    static constexpr bool PERM = true, AFTER_DRAIN = false;
    bf16_t* O; int ldc;
    __device__ __forceinline__ void operator()(const f32x4 (&acc)[2][2][4][2], const Unit& u, int wr, int wc, int fr, int fq) const {
        const int row0 = u.pm * BM + wr * 64 + fr; const int col0 = u.pn * HALF + wc * 32 + 8 * fq;
#pragma unroll
        for (int ai = 0; ai < 2; ++ai)
#pragma unroll
            for (int m = 0; m < 4; ++m) { bf16_t* rowp = O + (size_t)(row0 + ai * HALF + m * 16) * ldc + col0;
                const f32x4 g0 = acc[ai][0][m][0], g1 = acc[ai][0][m][1], u0 = acc[ai][1][m][0], u1 = acc[ai][1][m][1];
                f32x4 a, b;
#pragma unroll
                for (int e = 0; e < 4; ++e) { a[e] = silu_f(g0[e]) * u0[e]; b[e] = silu_f(g1[e]) * u1[e]; }
                u32x4 w; w.x = cvt_pk_bf16(a[0], a[1]); w.y = cvt_pk_bf16(a[2], a[3]); w.z = cvt_pk_bf16(b[0], b[1]); w.w = cvt_pk_bf16(b[2], b[3]);
                *(u32x4*)rowp = w; }
    }
};
struct EpiResid {
    static constexpr bool PERM = false, AFTER_DRAIN = false;
    const float* res; float* out; int ldc;
    __device__ __forceinline__ void operator()(const f32x4 (&acc)[2][2][4][2], const Unit& u, int wr, int wc, int fr, int fq) const {
        const int row0 = u.pm * BM + wr * 64 + fr; const int col0 = u.pn * BM + wc * 32 + 4 * fq;
#pragma unroll
        for (int ai = 0; ai < 2; ++ai)
#pragma unroll
            for (int m = 0; m < 4; ++m) { const size_t off = (size_t)(row0 + ai * HALF + m * 16) * ldc + col0;
#pragma unroll
                for (int bj = 0; bj < 2; ++bj)
#pragma unroll
                    for (int n = 0; n < 2; ++n) { const f32x4 r = *(const f32x4*)(res + off + bj * HALF + n * 16); *(f32x4*)(out + off + bj * HALF + n * 16) = r + acc[ai][bj][m][n]; } }
    }
};
template <class Epi, class Sched, bool ALIGN_EPI = false, bool SP2 = false>
__device__ __forceinline__ void gemm_phase(PG8_LAS unsigned char* lds, const Gemm g, const Sched& S, const Epi& E) {
    int tid_ = threadIdx.x; asm volatile("" : "+v"(tid_)); const int tid = tid_, wid = __builtin_amdgcn_readfirstlane(tid >> 6), lane = tid & 63, wr = wid >> 2, wc = wid & 3, fr = lane & 15, fq = lane >> 4;
    const int K = g.K, nt = K / BK;
    unsigned voffA[2], voffB[2];
#pragma unroll
    for (int i = 0; i < 2; ++i) { int R, C; stage_rc(tid * 16 + i * 8192, R, C); const int Rb = Epi::PERM ? ((R & ~31) + perm32(R & 31)) : R;
        voffA[i] = (unsigned)(R * K + C) * 2u; voffB[i] = (unsigned)(Rb * K + C) * 2u; }
    const size_t kstep = (size_t)(BK * 2);
    const size_t hstep = (size_t)HALF * K * 2;
    const size_t tstep = 2 * hstep;
    const unsigned ldsw = (unsigned)wid * 1024u;
    const int aoff = lds_byte(wr * 64 + fr, fq * 8), boff = lds_byte(wc * 32 + fr, fq * 8);
#define PG8_SA(b, h) (((b) * 2 + (h)) * HTB)
#define PG8_SB(b, h) ((4 + (b) * 2 + (h)) * HTB)
#define PG8_STAGE(bufoff, gbase, voff) do { _Pragma("unroll") for (int _i = 0; _i < 2; ++_i) \
        __builtin_amdgcn_global_load_lds((const unsigned*)((const char*)(gbase) + (voff)[_i]), (PG8_LAS unsigned*)(lds + (bufoff) + ldsw + _i * 8192), 16, 0, 0); } while (0)
#define PG8_LDA(dst, b, h) do { _Pragma("unroll") for (int m = 0; m < 4; ++m) _Pragma("unroll") for (int k = 0; k < 2; ++k) dst[m][k] = *(const PG8_LAS bf16x8*)(lds + PG8_SA(b, h) + aoff + m * 2048 + k * 1024); } while (0)
#define PG8_LDB(dst, b, h) do { _Pragma("unroll") for (int n = 0; n < 2; ++n) _Pragma("unroll") for (int k = 0; k < 2; ++k) dst[n][k] = *(const PG8_LAS bf16x8*)(lds + PG8_SB(b, h) + boff + n * 2048 + k * 1024); } while (0)
#define PG8_MMA(ai, bj, At, Bt) do { __builtin_amdgcn_s_setprio(1); _Pragma("unroll") for (int m = 0; m < 4; ++m) _Pragma("unroll") for (int n = 0; n < 2; ++n) _Pragma("unroll") for (int k = 0; k < 2; ++k) \
        acc[ai][bj][m][n] = __builtin_amdgcn_mfma_f32_16x16x32_bf16(Bt[n][k], At[m][k], acc[ai][bj][m][n], 0, 0, 0); __builtin_amdgcn_s_setprio(0); } while (0)
#define PG8_WAIT_V(n) asm volatile("s_waitcnt vmcnt(" #n ")" ::: "memory")
#define PG8_WAIT_L(n) asm volatile("s_waitcnt lgkmcnt(" #n ")" ::: "memory")
#define PG8_BAR __builtin_amdgcn_s_barrier()
#define PG8_SCHED __builtin_amdgcn_sched_barrier(0)
    Unit cur, nxt; int ui = 0;
    if (!S.next(0, cur)) return;
    f32x4 acc[2][2][4][2];
#pragma unroll
    for (int a = 0; a < 2; ++a)
#pragma unroll
        for (int b = 0; b < 2; ++b)
#pragma unroll
            for (int m = 0; m < 4; ++m)
#pragma unroll
                for (int n = 0; n < 2; ++n) acc[a][b][m][n] = (f32x4){0.f, 0.f, 0.f, 0.f};
    bf16x8 At[4][2], B0[2][2], B1[2][2];
    const char* cA = (const char*)g.A + (size_t)cur.pm * tstep; const char* cB = (const char*)g.Bt + (size_t)cur.pn * tstep;
    S.a_ready(cur);
    if constexpr (SP2) {
        PG8_STAGE(PG8_SB(0, 0), cB, voffB); PG8_STAGE(PG8_SB(0, 1), cB + hstep, voffB); PG8_STAGE(PG8_SA(0, 0), cA, voffA); PG8_STAGE(PG8_SA(0, 1), cA + hstep, voffA);
        if (wr == 1) PG8_BAR;
        PG8_WAIT_V(2); PG8_BAR;
        PG8_STAGE(PG8_SB(1, 0), cB + kstep, voffB); PG8_STAGE(PG8_SA(1, 0), cA + kstep, voffA); PG8_STAGE(PG8_SB(1, 1), cB + hstep + kstep, voffB);
        PG8_WAIT_V(6); PG8_BAR;
    } else {
        PG8_STAGE(PG8_SB(0, 0), cB, voffB); PG8_STAGE(PG8_SA(0, 0), cA, voffA); PG8_STAGE(PG8_SB(0, 1), cB + hstep, voffB); PG8_STAGE(PG8_SA(0, 1), cA + hstep, voffA);
        if (wr == 1) PG8_BAR;
        PG8_WAIT_V(4); PG8_BAR;
        PG8_STAGE(PG8_SB(1, 0), cB + kstep, voffB); PG8_STAGE(PG8_SA(1, 0), cA + kstep, voffA); PG8_STAGE(PG8_SB(1, 1), cB + hstep + kstep, voffB);
        PG8_WAIT_V(6); PG8_BAR;
    }
    for (;;) {
        const bool has_next = S.next(ui + 1, nxt);
        const char* nA = has_next ? (const char*)g.A + (size_t)nxt.pm * tstep : cA; const char* nB = has_next ? (const char*)g.Bt + (size_t)nxt.pn * tstep : cB;
        for (int t = 0; t < nt; t += 2) {
            const bool last = (t == nt - 2);
            const char* a1 = cA + (size_t)(t + 1) * kstep;
            const char* a2 = last ? nA : cA + (size_t)(t + 2) * kstep; const char* b2 = last ? nB : cB + (size_t)(t + 2) * kstep;
            const char* a3 = a2 + kstep; const char* b3 = b2 + kstep;
            if (last && has_next) S.a_ready(nxt);
            if constexpr (SP2) {
            PG8_LDB(B0, 0, 0); PG8_LDB(B1, 0, 1); PG8_SCHED; PG8_LDA(At, 0, 0); PG8_STAGE(PG8_SA(1, 1), a1 + hstep, voffA);
            PG8_WAIT_V(8); PG8_WAIT_L(0); PG8_BAR; PG8_MMA(0, 0, At, B0); PG8_MMA(0, 1, At, B1); PG8_BAR; PG8_SCHED;
            PG8_LDA(At, 0, 1); PG8_STAGE(PG8_SB(0, 0), b2, voffB); PG8_STAGE(PG8_SB(0, 1), b2 + hstep, voffB); PG8_STAGE(PG8_SA(0, 0), a2, voffA);
            PG8_WAIT_V(8); PG8_WAIT_L(0); PG8_BAR; PG8_MMA(1, 0, At, B0); PG8_MMA(1, 1, At, B1); PG8_BAR; PG8_SCHED;
            PG8_LDB(B0, 1, 0); PG8_LDB(B1, 1, 1); PG8_SCHED; PG8_LDA(At, 1, 0); PG8_STAGE(PG8_SA(0, 1), a2 + hstep, voffA);
            PG8_WAIT_V(8); PG8_WAIT_L(0); PG8_BAR; PG8_MMA(0, 0, At, B0); PG8_MMA(0, 1, At, B1); PG8_BAR; PG8_SCHED;
            PG8_LDA(At, 1, 1); PG8_STAGE(PG8_SB(1, 0), b3, voffB); PG8_STAGE(PG8_SB(1, 1), b3 + hstep, voffB); PG8_STAGE(PG8_SA(1, 0), a3, voffA);
            PG8_WAIT_V(8); PG8_WAIT_L(0); PG8_BAR; PG8_MMA(1, 0, At, B0); PG8_MMA(1, 1, At, B1); PG8_BAR; PG8_SCHED;
            } else {
            PG8_LDB(B0, 0, 0); PG8_SCHED; PG8_LDA(At, 0, 0); PG8_STAGE(PG8_SA(1, 1), a1 + hstep, voffA);
            PG8_WAIT_L(8); PG8_BAR; PG8_WAIT_L(0); PG8_MMA(0, 0, At, B0); PG8_BAR; PG8_SCHED;
            PG8_LDB(B1, 0, 1); PG8_STAGE(PG8_SB(0, 0), b2, voffB);
            PG8_BAR; PG8_WAIT_L(0); PG8_MMA(0, 1, At, B1); PG8_BAR;
            PG8_LDA(At, 0, 1); PG8_STAGE(PG8_SA(0, 0), a2, voffA);
            PG8_BAR; PG8_WAIT_L(0); PG8_MMA(1, 0, At, B0); PG8_BAR; PG8_SCHED;
            PG8_STAGE(PG8_SB(0, 1), b2 + hstep, voffB);
            PG8_WAIT_V(6); PG8_BAR; PG8_MMA(1, 1, At, B1); PG8_BAR;
            PG8_LDB(B0, 1, 0); PG8_SCHED; PG8_LDA(At, 1, 0); PG8_STAGE(PG8_SA(0, 1), a2 + hstep, voffA);
            PG8_WAIT_L(8); PG8_BAR; PG8_WAIT_L(0); PG8_MMA(0, 0, At, B0); PG8_BAR; PG8_SCHED;
            PG8_LDB(B1, 1, 1); PG8_STAGE(PG8_SB(1, 0), b3, voffB);
            PG8_BAR; PG8_WAIT_L(0); PG8_MMA(0, 1, At, B1); PG8_BAR;
            PG8_LDA(At, 1, 1); PG8_STAGE(PG8_SA(1, 0), a3, voffA);
            PG8_BAR; PG8_WAIT_L(0); PG8_MMA(1, 0, At, B0); PG8_BAR; PG8_SCHED;
            PG8_STAGE(PG8_SB(1, 1), b3 + hstep, voffB);
            PG8_WAIT_V(6); PG8_BAR; PG8_MMA(1, 1, At, B1); PG8_BAR;
            }
        }
        if constexpr (ALIGN_EPI) { if (wr == 0) PG8_BAR; }
        if constexpr (!Epi::AFTER_DRAIN) { E(acc, cur, wr, wc, fr, fq); S.done(cur); }
        if (!has_next) break;
#pragma unroll
        for (int a = 0; a < 2; ++a)
#pragma unroll
            for (int b = 0; b < 2; ++b)
#pragma unroll
                for (int m = 0; m < 4; ++m)
#pragma unroll
                    for (int n = 0; n < 2; ++n) acc[a][b][m][n] = (f32x4){0.f, 0.f, 0.f, 0.f};
        cur = nxt; cA = nA; cB = nB; ++ui;
        if constexpr (ALIGN_EPI) { if (wr == 1) PG8_BAR; }
    }
    PG8_WAIT_V(0);
    if constexpr (!ALIGN_EPI) { if (wr == 0) PG8_BAR; }
    PG8_BAR;
    if constexpr (Epi::AFTER_DRAIN) { E.fused(acc, cur, wr, wc, fr, fq, lds, wid, lane); S.done(cur); }
#undef PG8_SA
#undef PG8_SB
#undef PG8_STAGE
#undef PG8_LDA
#undef PG8_LDB
#undef PG8_MMA
#undef PG8_WAIT_V
#undef PG8_WAIT_L
#undef PG8_BAR
#undef PG8_SCHED
}
}
typedef float f32x2_t __attribute__((ext_vector_type(2)));
#define LAS __attribute__((address_space(3)))
typedef unsigned short bf16;
typedef float f32x4 __attribute__((ext_vector_type(4)));
typedef unsigned u32x4 __attribute__((ext_vector_type(4)));
typedef unsigned u32x2 __attribute__((ext_vector_type(2)));

constexpr int BATCH = 8, SEQ = 2048, DM = 1024, DEPTH = 4, M = BATCH * SEQ;
constexpr int INDIM = 3344, NPROJ = 3328, DFF = 2816, NGU = 2 * DFF, NBQKV = 1536;
constexpr int PC_QA = 0, PC_KA = 256, PC_VA = 512, PC_QB = 768, PC_KB = 1280, PC_VB = 1792, PC_ZB = 2304, PC_QC = 2816, PC_KC = 3072, PC_VC = 3200;
constexpr float EPS = 1e-6f;
constexpr int NPH = 10;
constexpr int LDS_BYTES = 147456;

constexpr size_t WS_CTL = 0;
constexpr size_t WS_G = 65536;
constexpr size_t WS_BETA = WS_G + (size_t)M * 8 * 4;
constexpr size_t WS_WIN = WS_BETA + (size_t)M * 8 * 4;
constexpr size_t WS_WO = WS_WIN + (size_t)NPROJ * DM * 2;
constexpr size_t WS_WGU = WS_WO + (size_t)DM * DM * 2;
constexpr size_t WS_WD = WS_WGU + (size_t)NGU * DM * 2;
constexpr size_t WS_XN = WS_WD + (size_t)DM * DFF * 2;
constexpr size_t WS_PROJ = WS_XN + (size_t)M * DM * 2;
constexpr size_t WS_X1 = WS_PROJ + (size_t)M * NPROJ * 2;
constexpr size_t WS_NW = WS_X1;
constexpr size_t WS_QB = WS_X1 + (size_t)M * 512 * 4;
constexpr size_t WS_KB = WS_QB + (size_t)M * 512 * 2;
constexpr size_t WS_U = WS_XN;
constexpr size_t WS_VB = WS_X1 + (size_t)M * DM * 4;
constexpr size_t WS_MIX = WS_VB + (size_t)M * 512 * 2;
constexpr size_t WS_QKD = WS_MIX + (size_t)M * DM * 2;
constexpr size_t WS_GCL = WS_QKD + (size_t)2048 * 4096 * 2;
constexpr size_t WS_OF = WS_GCL + (size_t)2048 * 64 * 4;
constexpr size_t WS_OB = WS_OF + (size_t)M * 512 * 2;
constexpr size_t WS_VTA = WS_OB + (size_t)M * 512 * 2;
constexpr size_t WS_VTC = WS_VTA + (size_t)M * 256 * 2;
constexpr size_t WS_VT3 = WS_VTC + (size_t)M * 128 * 2;
constexpr size_t WS_END = WS_VT3 + (size_t)M * 256 * 2;

struct Params { const float* in[15]; float* out; unsigned char* ws; int ph_lo, ph_hi; };
enum { I_X = 0, I_NORM1, I_WIN, I_QNA, I_KNA, I_CONV, I_ALOG, I_DTB, I_ONORM, I_QNC, I_KNC, I_WOUT, I_NORM2, I_WGU, I_WD };

__device__ __forceinline__ float bf2f(unsigned v) { return __uint_as_float(v << 16); }
__device__ __forceinline__ float bflo(unsigned v) { return __uint_as_float(v << 16); }
__device__ __forceinline__ float bfhi(unsigned v) { return __uint_as_float(v & 0xffff0000u); }
__device__ __forceinline__ unsigned pk2(float lo, float hi) { unsigned r; asm("v_cvt_pk_bf16_f32 %0, %1, %2" : "=v"(r) : "v"(lo), "v"(hi)); return r; }
__device__ __forceinline__ unsigned f2bf(float f) { return pk2(f, f) & 0xffffu; }
template <int CTRL> __device__ __forceinline__ float dpp_add(float v) { return v + __int_as_float(__builtin_amdgcn_update_dpp(0, __float_as_int(v), CTRL, 0xf, 0xf, true)); }
__device__ __forceinline__ float wave_sum(float v) {
    v = dpp_add<0xB1>(v); v = dpp_add<0x4E>(v); v = dpp_add<0x141>(v); v = dpp_add<0x140>(v);
    { const auto r16 = __builtin_amdgcn_permlane16_swap(__float_as_uint(v), __float_as_uint(v), false, false); v = __uint_as_float(r16[0]) + __uint_as_float(r16[1]); }
    { const auto r32 = __builtin_amdgcn_permlane32_swap(__float_as_uint(v), __float_as_uint(v), false, false); v = __uint_as_float(r32[0]) + __uint_as_float(r32[1]); }
    return v;
}
#define LDS_WAIT() asm volatile("s_waitcnt lgkmcnt(0)" ::: "memory")

struct Ctx { int tid, lane, wave, gw, ngw; LAS unsigned char* lds; };

__device__ __forceinline__ void tr_item(const float* __restrict__ W, int ldw, int K, int src_col0, bf16* WT, int dst_row0, int kb, LAS float* scr, int lane) {
    const int k0 = 64 * kb;
#pragma unroll 8
    for (int i = 0; i < 32; ++i) { const int kk = 2 * i + (lane >> 5); scr[kk * 33 + (lane & 31)] = W[(size_t)(k0 + kk) * ldw + src_col0 + (lane & 31)]; }
    LDS_WAIT();
    const int c = lane & 7;
#pragma unroll
    for (int j = 0; j < 4; ++j) { const int n = (lane >> 3) + 8 * j; const LAS float* s = scr + (8 * c) * 33 + n;
        u32x4 o; o.x = pk2(s[0 * 33], s[1 * 33]); o.y = pk2(s[2 * 33], s[3 * 33]); o.z = pk2(s[4 * 33], s[5 * 33]); o.w = pk2(s[6 * 33], s[7 * 33]);
        *(u32x4*)(WT + (size_t)(dst_row0 + n) * K + k0 + 8 * c) = o; }
    LDS_WAIT();
}

__device__ __forceinline__ void convert_weights(const Params& P, const Ctx& C, int L) {
    LAS float* scr = (LAS float*)(C.lds + C.wave * 16384);
    unsigned char* ws = P.ws;
    const float* win = P.in[I_WIN] + (size_t)L * DM * INDIM;
    const float* wout = P.in[I_WOUT] + (size_t)L * DM * DM;
    const float* wgu = P.in[I_WGU] + (size_t)L * DM * NGU;
    const float* wd = P.in[I_WD] + (size_t)L * DFF * DM;
    constexpr int N_IN = 16 * (NPROJ / 32), N_OUT = 16 * (DM / 32), N_GU = 16 * (NGU / 32), N_D = (DFF / 64) * (DM / 32);
    for (int it = C.gw; it < N_IN + N_OUT + N_GU + N_D; it += C.ngw) {
        int r = it;
        if (r < N_IN) { const int kb = r / (NPROJ / 32), nb = r % (NPROJ / 32), d0 = 32 * nb; tr_item(win, INDIM, DM, d0 < 2816 ? d0 : d0 + 16, (bf16*)(ws + WS_WIN), d0, kb, scr, C.lane); continue; }
        r -= N_IN;
        if (r < N_OUT) { const int kb = r / 32, nb = r % 32; tr_item(wout, DM, DM, 32 * nb, (bf16*)(ws + WS_WO), 32 * nb, kb, scr, C.lane); continue; }
        r -= N_OUT;
        if (r < N_GU) { const int kb = r / (NGU / 32), sb = r % (NGU / 32), j0 = 32 * sb; const int isup = j0 >= DFF, j = isup ? j0 - DFF : j0;
            tr_item(wgu, NGU, DM, j0, (bf16*)(ws + WS_WGU), (j / 128) * 256 + isup * 128 + (j % 128), kb, scr, C.lane); continue; }
        r -= N_GU;
        { const int kb = r / 32, nb = r % 32; tr_item(wd, DM, DFF, 32 * nb, (bf16*)(ws + WS_WD), 32 * nb, kb, scr, C.lane); }
    }
}

template <bool WITH_AB>
__device__ __forceinline__ void norm_rows(const Params& P, const Ctx& C, int L, const float* x, const float* nw) {
    bf16* XN = (bf16*)(P.ws + WS_XN);
    const LAS float* wab = (const LAS float*)C.lds;
    constexpr int RB = 4;
    for (int m0 = C.gw; m0 < M; m0 += RB * C.ngw) {
        f32x4 v[RB][4]; float rs[RB];
#pragma unroll
        for (int j = 0; j < RB; ++j) { const int m = m0 + j * C.ngw < M ? m0 + j * C.ngw : m0; const f32x4* xr = (const f32x4*)(x + (size_t)m * DM) + C.lane;
#pragma unroll
            for (int q = 0; q < 4; ++q) v[j][q] = xr[64 * q]; }
#pragma unroll
        for (int j = 0; j < RB; ++j) { float s = 0.f;
#pragma unroll
            for (int q = 0; q < 4; ++q) s += (v[j][q].x * v[j][q].x + v[j][q].y * v[j][q].y) + (v[j][q].z * v[j][q].z + v[j][q].w * v[j][q].w);
            rs[j] = s; }
#pragma unroll
        for (int j = 0; j < RB; ++j) rs[j] = __builtin_amdgcn_rsqf(wave_sum(rs[j]) * (1.0f / DM) + EPS);
#pragma unroll
        for (int q = 0; q < 4; ++q) { const f32x4 w4 = ((const f32x4*)nw)[C.lane + 64 * q];
#pragma unroll
            for (int j = 0; j < RB; ++j) v[j][q] = v[j][q] * rs[j] * w4; }
#pragma unroll
        for (int j = 0; j < RB; ++j) { const int m = m0 + j * C.ngw; if (m < M) { u32x2* o8 = (u32x2*)(XN + (size_t)m * DM) + C.lane;
#pragma unroll
            for (int q = 0; q < 4; ++q) { u32x2 o; o.x = pk2(v[j][q].x, v[j][q].y); o.y = pk2(v[j][q].z, v[j][q].w); o8[64 * q] = o; } } }
        if constexpr (WITH_AB) {
            float mine[RB];
#pragma unroll
            for (int j = 0; j < RB; ++j) mine[j] = 0.f;
#pragma unroll 2
            for (int c = 0; c < 16; ++c) {
                f32x2_t a2[RB];
#pragma unroll
                for (int j = 0; j < RB; ++j) a2[j] = (f32x2_t){0.f, 0.f};
#pragma unroll
                for (int q = 0; q < 4; ++q) { const f32x4 w4 = *(const LAS f32x4*)(wab + c * 1024 + 4 * C.lane + 256 * q);
#pragma unroll
                    for (int j = 0; j < RB; ++j) { a2[j] += (f32x2_t){v[j][q].x, v[j][q].y} * (f32x2_t){w4.x, w4.y}; a2[j] += (f32x2_t){v[j][q].z, v[j][q].w} * (f32x2_t){w4.z, w4.w}; } }
#pragma unroll
                for (int j = 0; j < RB; ++j) { const float a = wave_sum(a2[j].x + a2[j].y); if (C.lane == c) mine[j] = a; }
            }
#pragma unroll
            for (int j = 0; j < RB; ++j) { const int m = m0 + j * C.ngw; if (m < M) {
                if (C.lane < 8) {
                    const float al = P.in[I_ALOG][L * 8 + C.lane], dtb = P.in[I_DTB][L * 8 + C.lane];
                    const float xx = mine[j] + dtb; const float sp = xx > 20.f ? xx : log1pf(expf(xx));
                    ((float*)(P.ws + WS_G))[(size_t)m * 8 + C.lane] = -expf(al) * sp;
                } else if (C.lane < 16) {
                    ((float*)(P.ws + WS_BETA))[(size_t)m * 8 + C.lane - 8] = 1.0f / (1.0f + expf(-mine[j]));
                } } }
        }
    }
}

__device__ __forceinline__ void phase_n1(const Params& P, const Ctx& C, int L) {
    convert_weights(P, C, L);
    __syncthreads();
    {
        const float* win = P.in[I_WIN] + (size_t)L * DM * INDIM + 2816;
        LAS float* wab = (LAS float*)C.lds;
        for (int e = C.tid; e < 16 * 1024; e += 512) { const int k = e >> 4, c = e & 15; wab[c * 1024 + k] = win[(size_t)k * INDIM + c]; }
    }
    __syncthreads();
    const float* x = L == 0 ? P.in[I_X] : P.out;
    norm_rows<true>(P, C, L, x, P.in[I_NORM1] + L * DM);
    __syncthreads();
}

__device__ __forceinline__ void phase_prep(const Params& P, const Ctx& C, int L) {
    bf16* PROJ = (bf16*)(P.ws + WS_PROJ);
    bf16* QB = (bf16*)(P.ws + WS_QB); bf16* KB = (bf16*)(P.ws + WS_KB); bf16* VB = (bf16*)(P.ws + WS_VB);
    const int lane = C.lane;
    const float qna = P.in[I_QNA][L * 64 + lane], kna = P.in[I_KNA][L * 64 + lane], qnc = P.in[I_QNC][L * 64 + lane], knc = P.in[I_KNC][L * 64 + lane];
    const float invA = exp2f(-(float)(lane & 7) * (1.0f / 8.0f) * 18.931568569324174f);
    const float invC = exp2f(-(float)(lane & 15) * (1.0f / 16.0f) * 13.287712379549449f);
    const float* cw = P.in[I_CONV] + (size_t)L * 5 * NBQKV;
    for (int tb = C.gw; tb < M / 8; tb += C.ngw) {
      const int tokb = tb * 8, tbt = tokb & (SEQ - 1);
#pragma unroll 1
      for (int jb = 0; jb < 8; jb += 4) {
        unsigned xa4[4][8], xc4[4][6];
#pragma unroll
        for (int jj = 0; jj < 4; ++jj) { const bf16* prl = PROJ + (size_t)(tokb + jb + jj) * NPROJ;
#pragma unroll
            for (int v = 0; v < 8; ++v) xa4[jj][v] = prl[(v < 4 ? PC_QA : PC_KA) + (v & 3) * 64 + lane];
#pragma unroll
            for (int v = 0; v < 6; ++v) xc4[jj][v] = prl[(v < 4 ? PC_QC + v * 64 : PC_KC + (v - 4) * 64) + lane]; }
#pragma unroll
       for (int jj = 0; jj < 4; ++jj) {
        const int j = jb + jj;
        const int tok = tokb + j, t = tbt + j;
        bf16* pr = PROJ + (size_t)tok * NPROJ;
        unsigned xa[8], xc[6];
#pragma unroll
        for (int v = 0; v < 8; ++v) xa[v] = xa4[jj][v];
#pragma unroll
        for (int v = 0; v < 6; ++v) xc[v] = xc4[jj][v];
        float sA, cA;
        { float rev = (float)t * invA * 0.15915494309189535f; rev -= floorf(rev); sA = __builtin_amdgcn_sinf(rev); cA = __builtin_amdgcn_cosf(rev); }
        float ssa[8];
#pragma unroll
        for (int v = 0; v < 8; ++v) { const float x = bf2f(xa[v]); ssa[v] = wave_sum(x * x); }
#pragma unroll
        for (int v = 0; v < 8; ++v) {
            float y = bf2f(xa[v]) * (__builtin_amdgcn_rsqf(ssa[v] * (1.0f / 64.0f) + EPS)) * (v < 4 ? qna : kna);
            const float pa = __int_as_float(__builtin_amdgcn_update_dpp(0, __float_as_int(y), 0x128, 0xf, 0xf, true));
            if (lane < 8) y = y * cA - pa * sA; else if (lane < 16) y = y * cA + pa * sA;
            if (v < 4) y *= 0.18033688011112042f;
            pr[(v < 4 ? PC_QA : PC_KA) + (v & 3) * 64 + lane] = (bf16)f2bf(y);
        }
        float sC, cC;
        { const float pos = lane < 32 ? (float)(t >> 6) : (float)(t & 63); float rev = pos * invC * 0.15915494309189535f; rev -= floorf(rev); sC = __builtin_amdgcn_sinf(rev); cC = __builtin_amdgcn_cosf(rev); }
        float ssc[6];
#pragma unroll
        for (int v = 0; v < 6; ++v) { const float x = bf2f(xc[v]); ssc[v] = wave_sum(x * x); }
#pragma unroll
        for (int v = 0; v < 6; ++v) {
            float y = bf2f(xc[v]) * (__builtin_amdgcn_rsqf(ssc[v] * (1.0f / 64.0f) + EPS)) * (v < 4 ? qnc : knc);
            const float pa = __shfl_xor(y, 16);
            if ((lane & 16) == 0) y = y * cC - pa * sC; else y = y * cC + pa * sC;
            if (v < 4) y *= 0.18033688011112042f;
            pr[(v < 4 ? PC_QC + v * 64 : PC_KC + (v - 4) * 64) + lane] = (bf16)f2bf(y);
        }
       }
      }
#pragma unroll 1
      for (int part = 0; part < 3; ++part) {
        const bf16* src = PROJ + PC_QB + part * 512 + 2 * lane;
        f32x2_t w2[4][5]; unsigned rows[12][4];
#pragma unroll
        for (int h = 0; h < 4; ++h)
#pragma unroll
            for (int d = 0; d < 5; ++d) w2[h][d] = *(const f32x2_t*)(cw + d * NBQKV + part * 512 + h * 128 + 2 * lane);
#pragma unroll
        for (int rr = 0; rr < 12; ++rr) { const int tt = tbt + rr - 2;
#pragma unroll
            for (int h = 0; h < 4; ++h) rows[rr][h] = (tt >= 0 && tt < SEQ) ? *(const unsigned*)(src + (size_t)(tokb + rr - 2) * NPROJ + h * 128) : 0u; }
        bf16* dst = (part == 0 ? QB : (part == 1 ? KB : VB)) + 2 * lane;
#pragma unroll
        for (int j = 0; j < 8; ++j) {
            float a0[4], a1[4], ss[4];
#pragma unroll
            for (int h = 0; h < 4; ++h) { f32x2_t xx = (f32x2_t){0.f, 0.f};
#pragma unroll
                for (int d = 0; d < 5; ++d) xx += w2[h][d] * (f32x2_t){bflo(rows[j + d][h]), bfhi(rows[j + d][h])};
                const float x0 = xx.x, x1 = xx.y;
                a0[h] = x0 * __builtin_amdgcn_rcpf(1.0f + __expf(-x0)); a1[h] = x1 * __builtin_amdgcn_rcpf(1.0f + __expf(-x1)); ss[h] = a0[h] * a0[h] + a1[h] * a1[h]; }
            if (part < 2) {
#pragma unroll
                for (int h = 0; h < 4; ++h) ss[h] = wave_sum(ss[h]);
#pragma unroll
                for (int h = 0; h < 4; ++h) { float sc = __builtin_amdgcn_rsqf(ss[h] + EPS); if (part == 0) sc *= 0.08838834764831845f; a0[h] *= sc; a1[h] *= sc; } }
#pragma unroll
            for (int h = 0; h < 4; ++h) *(unsigned*)(dst + (size_t)(tokb + j) * 512 + h * 128) = pk2(a0[h], a1[h]);
        }
      }
    }
    {   LAS bf16* scr = (LAS bf16*)(C.lds + C.wave * 16384);
        for (int it = C.gw; it < BATCH * 6 * 32 + BATCH * 4 * 16 * 2; it += C.ngw) {
            const bf16* src; bf16* dst; size_t rstep = NPROJ, dstep = SEQ;
            if (it < BATCH * 6 * 32) { const int b = it / 192, hs = (it / 32) % 6, tb = it & 31;
                src = PROJ + ((size_t)b * SEQ + tb * 64) * NPROJ + (hs < 4 ? PC_VA + 64 * hs : PC_VC + 64 * (hs - 4)) + lane;
                dst = (hs < 4 ? (bf16*)(P.ws + WS_VTA) + ((size_t)(b * 4 + hs) * 64) * SEQ : (bf16*)(P.ws + WS_VTC) + ((size_t)(b * 2 + hs - 4) * 64) * SEQ) + tb * 64 + lane;
            } else { const int idx = it - BATCH * 6 * 32, b = idx >> 7, h = (idx >> 5) & 3, rr = (idx >> 1) & 15, half = idx & 1;
                src = PROJ + ((size_t)b * SEQ + rr + 16 * 64 * half) * NPROJ + PC_VA + 64 * h + lane; rstep = (size_t)16 * NPROJ;
                dst = (bf16*)(P.ws + WS_VT3) + ((size_t)((b * 4 + h) * 16 + rr) * 64) * 128 + half * 64 + lane; dstep = 128; }
#pragma unroll 8
            for (int i = 0; i < 64; ++i) scr[i * 66 + lane] = src[(size_t)i * rstep];
            LDS_WAIT();
#pragma unroll 8
            for (int d = 0; d < 64; ++d) dst[(size_t)d * dstep] = scr[lane * 66 + d];
            LDS_WAIT(); }
    }
}

#define LDS_BARRIER() do { asm volatile("s_waitcnt lgkmcnt(0)" ::: "memory"); __builtin_amdgcn_s_barrier(); asm volatile("" ::: "memory"); } while (0)
typedef short bf16x8_t __attribute__((ext_vector_type(8)));
typedef float f32x16_t __attribute__((ext_vector_type(16)));
typedef short s16x4_t __attribute__((ext_vector_type(4)));
__device__ __forceinline__ unsigned cvtpk(float lo, float hi) { unsigned r; asm volatile("v_cvt_pk_bf16_f32 %0, %1, %2" : "=v"(r) : "v"(lo), "v"(hi)); return r; }
template <int R0, int NR> __device__ __forceinline__ void b1_rows(f32x2_t (&sol)[32], const LAS float* Ar) {
#pragma unroll
    for (int ip = (R0 < 1 ? 1 : R0); ip < R0 + NR; ++ip) { f32x2_t a01 = (f32x2_t){0.f, 0.f}, a23 = (f32x2_t){0.f, 0.f};
#pragma unroll
        for (int j4 = 0; j4 < (ip + 3) / 4; ++j4) { const f32x4 a4 = *(const LAS f32x4*)(Ar + ip * 64 + 4 * j4);
            a01 -= (f32x2_t){a4.x, a4.y} * sol[2 * j4]; a23 -= (f32x2_t){a4.z, a4.w} * sol[2 * j4 + 1]; }
        const f32x2_t a = a01 + a23;
        sol[ip >> 1][ip & 1] += a.x + a.y; }
}
__device__ __forceinline__ void b1_item(const Params& P, const Ctx& C, int item) {
    const int b = item >> 7, c = (item >> 2) & 31, h = item & 3;
    int tid_ = C.tid; asm volatile("" : "+v"(tid_)); const int tid = tid_, lane = tid_ & 63;
    LAS unsigned char* L = C.lds;
    LAS unsigned char* Ks = L; LAS unsigned char* Qs = L + 17408;
    LAS float* KKf = (LAS float*)(L + 34816); LAS float* QKf = (LAS float*)(L + 51456);
    LAS float* gcl = (LAS float*)(L + 68096); LAS float* bel = gcl + 128;
    LAS float* Ad = (LAS float*)(L + 69120);
    const bf16* QB = (const bf16*)(P.ws + WS_QB); const bf16* KB = (const bf16*)(P.ws + WS_KB); const bf16* VB = (const bf16*)(P.ws + WS_VB);
    const float* G = (const float*)(P.ws + WS_G); const float* BETA = (const float*)(P.ws + WS_BETA);
    const size_t tok0 = (size_t)b * SEQ + c * 64;
#pragma unroll
    for (int m = 0; m < 2; ++m) { const int e = tid + 512 * m, r = e >> 4, p = e & 15;
        *(LAS u32x4*)(Ks + r * 272 + p * 16) = *(const u32x4*)(KB + (tok0 + r) * 512 + h * 128 + p * 8);
        *(LAS u32x4*)(Qs + r * 272 + p * 16) = *(const u32x4*)(QB + (tok0 + r) * 512 + h * 128 + p * 8); }
    u32x4 vpre[2];
#pragma unroll
    for (int m = 0; m < 2; ++m) { const int e = tid + 512 * m, r = e >> 4, p = e & 15; vpre[m] = *(const u32x4*)(VB + (tok0 + r) * 512 + h * 128 + p * 8); }
    if (tid < 128) { const int dir = tid >> 6, i = dir ? 63 - lane : lane; const size_t tok = tok0 + i;
        float g = G[tok * 8 + dir * 4 + h];
#pragma unroll
        for (int o = 1; o < 64; o <<= 1) { const float t = __shfl_up(g, o); if (lane >= o) g += t; }
        gcl[dir * 64 + lane] = g; bel[dir * 64 + lane] = BETA[tok * 8 + dir * 4 + h]; }
    LDS_BARRIER();
    { const int prod = C.wave >> 2, ti = (C.wave >> 1) & 1, tj = C.wave & 1, r = lane & 31, hh = lane >> 5;
      f32x16_t acc;
#pragma unroll
      for (int e = 0; e < 16; ++e) acc[e] = 0.f;
      const LAS unsigned char* Ab = (prod ? Qs : Ks) + (32 * ti + r) * 272 + hh * 16; const LAS unsigned char* Bb = Ks + (32 * tj + r) * 272 + hh * 16;
#pragma unroll
      for (int ks = 0; ks < 8; ++ks) { const bf16x8_t a = *(const LAS bf16x8_t*)(Ab + ks * 32), bb = *(const LAS bf16x8_t*)(Bb + ks * 32); acc = __builtin_amdgcn_mfma_f32_32x32x16_bf16(a, bb, acc, 0, 0, 0); }
      LAS float* dst = prod ? QKf : KKf;
#pragma unroll
      for (int e = 0; e < 16; ++e) dst[(32 * ti + (e & 3) + 8 * (e >> 2) + 4 * hh) * 65 + 32 * tj + r] = acc[e]; }
    LDS_BARRIER();
#pragma unroll
    for (int m = 0; m < 2; ++m) { const int e = tid + 512 * m, r = e >> 4, p = e & 15; *(LAS u32x4*)(Qs + r * 272 + p * 16) = vpre[m]; }
    const int dir = C.wave >> 2, t = tid & 255;
    const int cs = (dir ? 31 - c : c) * 64 + ((b * 4 + h) * 2 + dir);
    { bf16* qkd = (bf16*)(P.ws + WS_QKD) + (size_t)cs * 4096;
#pragma unroll
      for (int n = 0; n < 8; ++n) { const int e = 2 * (t + 256 * n), ip = e >> 6, jp = e & 63, i = dir ? 63 - ip : ip; float qv[2];
#pragma unroll
          for (int c2 = 0; c2 < 2; ++c2) { const int jq = jp + c2, j = dir ? 63 - jq : jq;
              const float dec = jq <= ip ? __expf(gcl[dir * 64 + ip] - gcl[dir * 64 + jq]) : 0.f;
              Ad[dir * 4096 + ip * 64 + jq] = jq < ip ? bel[dir * 64 + ip] * KKf[i * 65 + j] * dec : 0.f;
              qv[c2] = QKf[i * 65 + j] * dec; }
          *(unsigned*)(qkd + ip * 64 + jp) = pk2(qv[0], qv[1]); }
      if (t < 64) ((float*)(P.ws + WS_GCL))[(size_t)cs * 64 + t] = gcl[dir * 64 + t]; }
    LDS_BARRIER();
    { f32x2_t sol[32];
      const LAS float* gd = gcl + dir * 64; const LAS float* bd = bel + dir * 64;
      const int rstep = dir ? -272 : 272;
      if (t < 128) { const LAS unsigned char* vp = Qs + (dir ? 63 * 272 : 0) + t * 2;
#pragma unroll
          for (int ip = 0; ip < 64; ++ip) sol[ip >> 1][ip & 1] = bf2f(*(const LAS bf16*)(vp + ip * rstep)) * bd[ip];
      } else { const LAS unsigned char* kp = Ks + (dir ? 63 * 272 : 0) + (t - 128) * 2;
#pragma unroll
          for (int ip = 0; ip < 64; ++ip) sol[ip >> 1][ip & 1] = bf2f(*(const LAS bf16*)(kp + ip * rstep)) * bd[ip] * __expf(gd[ip]);
      }
      const LAS float* Ar = Ad + dir * 4096;
#pragma unroll 1
      for (int rb = 0; rb < 22; ++rb) {
          switch (rb) {
          case 0: b1_rows<0, 8>(sol, Ar); break;
          case 1: b1_rows<8, 8>(sol, Ar); break;
          case 2: b1_rows<16, 4>(sol, Ar); break;
          case 3: b1_rows<20, 4>(sol, Ar); break;
          case 4: b1_rows<24, 4>(sol, Ar); break;
          case 5: b1_rows<28, 4>(sol, Ar); break;
          case 6: b1_rows<32, 2>(sol, Ar); break;
          case 7: b1_rows<34, 2>(sol, Ar); break;
          case 8: b1_rows<36, 2>(sol, Ar); break;
          case 9: b1_rows<38, 2>(sol, Ar); break;
          case 10: b1_rows<40, 2>(sol, Ar); break;
          case 11: b1_rows<42, 2>(sol, Ar); break;
          case 12: b1_rows<44, 2>(sol, Ar); break;
          case 13: b1_rows<46, 2>(sol, Ar); break;
          case 14: b1_rows<48, 2>(sol, Ar); break;
          case 15: b1_rows<50, 2>(sol, Ar); break;
          case 16: b1_rows<52, 2>(sol, Ar); break;
          case 17: b1_rows<54, 2>(sol, Ar); break;
          case 18: b1_rows<56, 2>(sol, Ar); break;
          case 19: b1_rows<58, 2>(sol, Ar); break;
          case 20: b1_rows<60, 2>(sol, Ar); break;
          case 21: b1_rows<62, 2>(sol, Ar); break;
          default: break; }
      }
      LDS_BARRIER();
      LAS unsigned char* img = L + 34816 + dir * 32768;
      const float sg = t < 128 ? 1.f : -1.f;
#pragma unroll
      for (int ip = 0; ip < 64; ++ip) *(LAS bf16*)(img + ip * 512 + t * 2) = (bf16)f2bf(sg * sol[ip >> 1][ip & 1]); }
    LDS_BARRIER();
    { const LAS unsigned char* img = L + 34816 + dir * 32768;
      bf16* Ud = (bf16*)(P.ws + WS_U) + (size_t)cs * 8192; bf16* Nd = (bf16*)(P.ws + WS_NW) + (size_t)cs * 8192;
#pragma unroll
      for (int m = 0; m < 8; ++m) { const int e = t + 256 * m, row = e >> 5, p = e & 31; const u32x4 w = *(const LAS u32x4*)(img + row * 512 + p * 16);
          *(u32x4*)((p < 16 ? Ud : Nd) + row * 128 + (p & 15) * 8) = w; } }
    LDS_BARRIER();
}

constexpr int B2_NW = 0, B2_QG = 17408, B2_QK = 34816, B2_KGT = 44032, B2_EGL = 62464, B2_BUF = 62976;
struct B2Regs { u32x4 nw[2], qk, qv[2], kv[2]; float gq[2], gk, glast; };
__device__ __forceinline__ void b2_load(const Params& P, int chain, int n, int tid_, B2Regs& R) {
    int tid = tid_; asm volatile("" : "+v"(tid));
    const int b = chain >> 3, h = (chain >> 1) & 3, dir = chain & 1, cs = n * 64 + chain, c = dir ? 31 - n : n;
    const size_t tok0 = (size_t)b * SEQ + c * 64;
    const float* gcl = (const float*)(P.ws + WS_GCL) + (size_t)cs * 64;
    const bf16* NWg = (const bf16*)(P.ws + WS_NW) + (size_t)cs * 8192; const bf16* QKg = (const bf16*)(P.ws + WS_QKD) + (size_t)cs * 4096;
    const bf16* QB = (const bf16*)(P.ws + WS_QB); const bf16* KB = (const bf16*)(P.ws + WS_KB);
#pragma unroll
    for (int m = 0; m < 2; ++m) R.nw[m] = *(const u32x4*)(NWg + (tid + 512 * m) * 8);
    R.qk = *(const u32x4*)(QKg + tid * 8);
#pragma unroll
    for (int m = 0; m < 2; ++m) { const int e = tid + 512 * m, ip = e >> 4, p = e & 15, i = dir ? 63 - ip : ip; R.qv[m] = *(const u32x4*)(QB + (tok0 + i) * 512 + h * 128 + p * 8); R.gq[m] = gcl[ip]; }
#pragma unroll
    for (int m = 0; m < 2; ++m) { const int e = tid + 512 * m, ip = e & 63, p = e >> 6, i = dir ? 63 - ip : ip; R.kv[m] = *(const u32x4*)(KB + (tok0 + i) * 512 + h * 128 + p * 8); }
    R.gk = gcl[tid & 63]; R.glast = gcl[63];
}
__device__ __forceinline__ void b2_write(const B2Regs& R, LAS unsigned char* buf, int tid_) {
    int tid = tid_; asm volatile("" : "+v"(tid));
#pragma unroll
    for (int m = 0; m < 2; ++m) { const int e = tid + 512 * m, r = e >> 4, p = e & 15; *(LAS u32x4*)(buf + B2_NW + r * 272 + p * 16) = R.nw[m]; }
    { const int r = tid >> 3, p = tid & 7; *(LAS u32x4*)(buf + B2_QK + r * 144 + p * 16) = R.qk; }
#pragma unroll
    for (int m = 0; m < 2; ++m) { const int e = tid + 512 * m, ip = e >> 4, p = e & 15; const u32x4 q = R.qv[m]; const float s = __expf(R.gq[m]);
        u32x4 o; o.x = cvtpk(bflo(q.x) * s, bfhi(q.x) * s); o.y = cvtpk(bflo(q.y) * s, bfhi(q.y) * s); o.z = cvtpk(bflo(q.z) * s, bfhi(q.z) * s); o.w = cvtpk(bflo(q.w) * s, bfhi(q.w) * s);
        *(LAS u32x4*)(buf + B2_QG + ip * 272 + p * 16) = o; }
    const float sk = __expf(R.glast - R.gk);
#pragma unroll
    for (int m = 0; m < 2; ++m) { const int e = tid + 512 * m, ip = e & 63, p = e >> 6; const u32x4 k = R.kv[m];
        LAS bf16* d = (LAS bf16*)(buf + B2_KGT) + (8 * p) * 72 + ip;
        d[0] = (bf16)f2bf(bflo(k.x) * sk); d[72] = (bf16)f2bf(bfhi(k.x) * sk); d[144] = (bf16)f2bf(bflo(k.y) * sk); d[216] = (bf16)f2bf(bfhi(k.y) * sk);
        d[288] = (bf16)f2bf(bflo(k.z) * sk); d[360] = (bf16)f2bf(bfhi(k.z) * sk); d[432] = (bf16)f2bf(bflo(k.w) * sk); d[504] = (bf16)f2bf(bfhi(k.w) * sk); }
    if (tid == 0) *(LAS float*)(buf + B2_EGL) = __expf(R.glast);
}
__device__ __forceinline__ bf16x8_t ldA(const LAS unsigned char* p) {
    const s16x4_t lo = *(const LAS s16x4_t*)p, hi = *(const LAS s16x4_t*)(p + 32);
    return (bf16x8_t){lo[0], lo[1], lo[2], lo[3], hi[0], hi[1], hi[2], hi[3]};
}
__device__ __forceinline__ bf16x8_t packB(const f32x4& a, const f32x4& b) {
    u32x4 w; w.x = cvtpk(a[0], a[1]); w.y = cvtpk(a[2], a[3]); w.z = cvtpk(b[0], b[1]); w.w = cvtpk(b[2], b[3]);
    return __builtin_bit_cast(bf16x8_t, w);
}
#define B2_PIPE(N) do { __builtin_amdgcn_sched_group_barrier(0x100, 4, 0); _Pragma("unroll") for (int i_ = 0; i_ < (N) - 4; ++i_) { __builtin_amdgcn_sched_group_barrier(0x008, 1, 0); __builtin_amdgcn_sched_group_barrier(0x100, 1, 0); } \
    __builtin_amdgcn_sched_group_barrier(0x008, 4, 0); } while (0)

template <int O0, int O1, int O2, int O3, int O4, int O5, int O6, int O7>
__device__ __forceinline__ void rd8(s16x4_t (&d)[8], unsigned base) {
    asm volatile("ds_read_b64 %0, %8 offset:%9\n\tds_read_b64 %1, %8 offset:%10\n\tds_read_b64 %2, %8 offset:%11\n\tds_read_b64 %3, %8 offset:%12\n\t"
                 "ds_read_b64 %4, %8 offset:%13\n\tds_read_b64 %5, %8 offset:%14\n\tds_read_b64 %6, %8 offset:%15\n\tds_read_b64 %7, %8 offset:%16"
                 : "=&v"(d[0]), "=&v"(d[1]), "=&v"(d[2]), "=&v"(d[3]), "=&v"(d[4]), "=&v"(d[5]), "=&v"(d[6]), "=&v"(d[7])
                 : "v"(base), "n"(O0), "n"(O1), "n"(O2), "n"(O3), "n"(O4), "n"(O5), "n"(O6), "n"(O7) : "memory");
}
struct Frag8 { s16x4_t lo[8], hi[8]; };
template <int OFF, int STEP_T, int KS2> __device__ __forceinline__ void frag_issue(Frag8& f, unsigned base) {
    rd8<OFF, OFF + STEP_T, OFF + 2 * STEP_T, OFF + 3 * STEP_T, OFF + KS2, OFF + KS2 + STEP_T, OFF + KS2 + 2 * STEP_T, OFF + KS2 + 3 * STEP_T>(f.lo, base);
    rd8<OFF + 32, OFF + STEP_T + 32, OFF + 2 * STEP_T + 32, OFF + 3 * STEP_T + 32, OFF + KS2 + 32, OFF + KS2 + STEP_T + 32, OFF + KS2 + 2 * STEP_T + 32, OFF + KS2 + 3 * STEP_T + 32>(f.hi, base);
}
__device__ __forceinline__ void frag_wait(Frag8& f) {
    asm volatile("s_waitcnt lgkmcnt(0)" : "+v"(f.lo[0]), "+v"(f.lo[1]), "+v"(f.lo[2]), "+v"(f.lo[3]), "+v"(f.lo[4]), "+v"(f.lo[5]), "+v"(f.lo[6]), "+v"(f.lo[7]) :: "memory");
    asm volatile("s_waitcnt lgkmcnt(0)" : "+v"(f.hi[0]), "+v"(f.hi[1]), "+v"(f.hi[2]), "+v"(f.hi[3]), "+v"(f.hi[4]), "+v"(f.hi[5]), "+v"(f.hi[6]), "+v"(f.hi[7]) :: "memory");
}
__device__ __forceinline__ bf16x8_t frag_get(const Frag8& f, int i) { return (bf16x8_t){f.lo[i][0], f.lo[i][1], f.lo[i][2], f.lo[i][3], f.hi[i][0], f.hi[i][1], f.hi[i][2], f.hi[i][3]}; }
template <int OFF, int STRIDE, int T0, int KS> __device__ __forceinline__ void b2_rd4(bf16x8_t (&A)[8], int slot, const LAS unsigned char* const (&q)[4]) {
#pragma unroll
    for (int t = 0; t < 4; ++t) { const int o = OFF + (16 * (T0 + t)) * STRIDE + 64 * (KS & ~1);
        const s16x4_t lo = *(const LAS s16x4_t*)(q[2 * (KS & 1)] + o), hi = *(const LAS s16x4_t*)(q[2 * (KS & 1) + 1] + o);
        A[slot + t] = (bf16x8_t){lo[0], lo[1], lo[2], lo[3], hi[0], hi[1], hi[2], hi[3]}; }
}
__device__ __forceinline__ void b2_step(LAS unsigned char* buf, f32x4 (&S)[8], const u32x4 (&uq)[2], LAS unsigned char* scr, bf16* Orow, int lane, int g, int l15) {
    *(LAS u32x4*)(scr + lane * 32) = uq[0]; *(LAS u32x4*)(scr + lane * 32 + 16) = uq[1];
    LDS_WAIT();
    unsigned short ur[4][4];
#pragma unroll
    for (int t = 0; t < 4; ++t)
#pragma unroll
        for (int r = 0; r < 4; ++r) ur[t][r] = *(const LAS bf16*)(scr + (16 * t + 4 * g + r) * 32 + l15 * 2);
    const LAS unsigned char* b272[4]; const LAS unsigned char* b144[4];
#pragma unroll
    for (int i = 0; i < 4; ++i) { b272[i] = buf + l15 * 272 + g * 8 + 32 * i; b144[i] = buf + l15 * 144 + g * 8 + 32 * i; asm volatile("" : "+v"(b272[i]), "+v"(b144[i])); }
    bf16x8_t A0[8], A1[8];
    b2_rd4<B2_NW, 272, 0, 0>(A0, 0, b272); b2_rd4<B2_NW, 272, 0, 1>(A0, 4, b272);
    f32x4 vn[4];
#pragma unroll
    for (int t = 0; t < 4; ++t)
#pragma unroll
        for (int r = 0; r < 4; ++r) vn[t][r] = bf2f(ur[t][r]);
    bf16x8_t Sb[4];
#pragma unroll
    for (int ks = 0; ks < 4; ++ks) Sb[ks] = packB(S[2 * ks], S[2 * ks + 1]);
    __builtin_amdgcn_sched_barrier(0);
    b2_rd4<B2_NW, 272, 0, 2>(A1, 0, b272); b2_rd4<B2_NW, 272, 0, 3>(A1, 4, b272);
#pragma unroll
    for (int i = 0; i < 8; ++i) vn[i & 3] = __builtin_amdgcn_mfma_f32_16x16x32_bf16(A0[i], Sb[i >> 2], vn[i & 3], 0, 0, 0);
    __builtin_amdgcn_sched_barrier(0);
    b2_rd4<B2_QG, 272, 0, 0>(A0, 0, b272); b2_rd4<B2_QG, 272, 0, 1>(A0, 4, b272);
#pragma unroll
    for (int i = 0; i < 8; ++i) vn[i & 3] = __builtin_amdgcn_mfma_f32_16x16x32_bf16(A1[i], Sb[2 + (i >> 2)], vn[i & 3], 0, 0, 0);
    __builtin_amdgcn_sched_barrier(0);
    bf16x8_t vb[2];
#pragma unroll
    for (int ks = 0; ks < 2; ++ks) vb[ks] = packB(vn[2 * ks], vn[2 * ks + 1]);
    f32x4 o[4];
#pragma unroll
    for (int t = 0; t < 4; ++t) o[t] = (f32x4){0.f, 0.f, 0.f, 0.f};
    b2_rd4<B2_QG, 272, 0, 2>(A1, 0, b272); b2_rd4<B2_QG, 272, 0, 3>(A1, 4, b272);
#pragma unroll
    for (int i = 0; i < 8; ++i) o[i & 3] = __builtin_amdgcn_mfma_f32_16x16x32_bf16(A0[i], Sb[i >> 2], o[i & 3], 0, 0, 0);
    __builtin_amdgcn_sched_barrier(0);
    b2_rd4<B2_QK, 144, 0, 0>(A0, 0, b144); b2_rd4<B2_QK, 144, 0, 1>(A0, 4, b144);
#pragma unroll
    for (int i = 0; i < 8; ++i) o[i & 3] = __builtin_amdgcn_mfma_f32_16x16x32_bf16(A1[i], Sb[2 + (i >> 2)], o[i & 3], 0, 0, 0);
    __builtin_amdgcn_sched_barrier(0);
    b2_rd4<B2_KGT, 144, 0, 0>(A1, 0, b144); b2_rd4<B2_KGT, 144, 4, 0>(A1, 4, b144);
#pragma unroll
    for (int i = 0; i < 8; ++i) o[i & 3] = __builtin_amdgcn_mfma_f32_16x16x32_bf16(A0[i], vb[i >> 2], o[i & 3], 0, 0, 0);
    __builtin_amdgcn_sched_barrier(0);
#pragma unroll
    for (int t = 0; t < 4; ++t)
#pragma unroll
        for (int r = 0; r < 4; ++r) *(LAS bf16*)(scr + (16 * t + 4 * g + r) * 32 + l15 * 2) = (bf16)f2bf(o[t][r]);
    LDS_WAIT();
    { const u32x4 w0 = *(const LAS u32x4*)(scr + lane * 32), w1 = *(const LAS u32x4*)(scr + lane * 32 + 16); *(u32x4*)Orow = w0; *(u32x4*)(Orow + 8) = w1; }
    const float egl = *(const LAS float*)(buf + B2_EGL);
#pragma unroll
    for (int t = 0; t < 8; ++t) S[t] = S[t] * egl;
    b2_rd4<B2_KGT, 144, 0, 1>(A0, 0, b144); b2_rd4<B2_KGT, 144, 4, 1>(A0, 4, b144);
#pragma unroll
    for (int i = 0; i < 8; ++i) S[i] = __builtin_amdgcn_mfma_f32_16x16x32_bf16(A1[i], vb[0], S[i], 0, 0, 0);
    __builtin_amdgcn_sched_barrier(0);
#pragma unroll
    for (int i = 0; i < 8; ++i) S[i] = __builtin_amdgcn_mfma_f32_16x16x32_bf16(A0[i], vb[1], S[i], 0, 0, 0);
}
__device__ __forceinline__ void b2_uload(const bf16* Urow, u32x4 (&uq)[2]) { uq[0] = *(const u32x4*)Urow; uq[1] = *(const u32x4*)(Urow + 8); }
__device__ __forceinline__ void b2_chain(const Params& P, const Ctx& C, int chain) {
    const int b = chain >> 3, h = (chain >> 1) & 3, dir = chain & 1;
    int tid_ = C.tid; asm volatile("" : "+v"(tid_)); const int tid = tid_, lane = tid & 63, g = lane >> 4, l15 = lane & 15;
    LAS unsigned char* base = C.lds;
    const int v0 = 16 * C.wave;
    const bf16* Ug = (const bf16*)(P.ws + WS_U) + (size_t)chain * 8192 + lane * 128 + v0;
    bf16* OUT = (bf16*)(P.ws + (dir ? WS_OB : WS_OF)) + (size_t)b * SEQ * 512 + (dir ? 63 - lane : lane) * 512 + h * 128 + v0;
    LAS unsigned char* scr = base + 2 * B2_BUF + C.wave * 2048;
    B2Regs R0, R1;
    u32x4 u0[2], u1[2];
    f32x4 S[8];
#pragma unroll
    for (int t = 0; t < 8; ++t) S[t] = (f32x4){0.f, 0.f, 0.f, 0.f};
    b2_load(P, chain, 0, tid, R0); b2_uload(Ug, u0);
    b2_load(P, chain, 1, tid, R1); b2_uload(Ug + (size_t)64 * 8192, u1);
    b2_write(R0, base, tid);
    LDS_BARRIER();
    for (int n = 0; n < 32; n += 2) {
        if (n + 2 < 32) b2_load(P, chain, n + 2, tid, R0);
        { const int c = dir ? 31 - n : n; b2_step(base, S, u0, scr, OUT + (size_t)c * 64 * 512, lane, g, l15); }
        if (n + 2 < 32) b2_uload(Ug + (size_t)(n + 2) * 64 * 8192, u0);
        b2_write(R1, base + B2_BUF, tid);
        LDS_BARRIER();
        if (n + 3 < 32) b2_load(P, chain, n + 3, tid, R1);
        { const int c = dir ? 31 - (n + 1) : n + 1; b2_step(base + B2_BUF, S, u1, scr, OUT + (size_t)c * 64 * 512, lane, g, l15); }
        if (n + 3 < 32) b2_uload(Ug + (size_t)(n + 3) * 64 * 8192, u1);
        if (n + 2 < 32) b2_write(R0, base, tid);
        LDS_BARRIER();
    }
}

constexpr int AT_K = 0, AT_V = 9216, AT_BUF = 18432, AT_ITEM = 40960;
template <int MODE>
__device__ __forceinline__ void attn_item(const Params& P, const Ctx& C, int item) {
    constexpr bool IS_A = MODE == 1;
    int tid_ = C.tid; asm volatile("" : "+v"(tid_)); const int tid = tid_, lane = tid & 63, r = lane & 31, hh = lane >> 5; const int wave = C.wave;
    LAS unsigned char* L = C.lds;
    const bf16* PROJ = (const bf16*)(P.ws + WS_PROJ); bf16* MIX = (bf16*)(P.ws + WS_MIX);
    int b, tw, qcol, kcol, vcol, ocol, kt_lo, kt_hi, hA = 0, rres = 0; const bf16* VT;
    if (MODE == 1) { b = item >> 5; const int h = (item >> 3) & 3, q0 = (item & 7) * 256; hA = h; VT = (const bf16*)(P.ws + WS_VTA) + ((size_t)(b * 4 + h) * 64) * SEQ; tw = q0 + 32 * wave; qcol = PC_QA + 64 * h; kcol = PC_KA + 64 * h; vcol = PC_VA + 64 * h; ocol = 64 * h;
        kt_lo = q0 - 256 < 0 ? 0 : (q0 - 256) >> 6; kt_hi = ((q0 + 511) >> 6) + 1; if (kt_hi > 32) kt_hi = 32; }
    else if (MODE == 2) { b = item >> 6; const int h = (item >> 4) & 3; hA = h; rres = item & 15; VT = (const bf16*)(P.ws + WS_VT3) + ((size_t)((b * 4 + h) * 16 + rres) * 64) * 128; tw = 32 * (wave & 3); qcol = PC_QA + 64 * h; kcol = PC_KA + 64 * h; vcol = 0; ocol = 0;
        kt_lo = 0; kt_hi = 2; }
    else { b = item >> 5; const int kvh = (item >> 4) & 1, q0 = (item & 15) * 128, qh = kvh * 2 + (wave >> 2); VT = (const bf16*)(P.ws + WS_VTC) + ((size_t)(b * 2 + kvh) * 64) * SEQ; tw = q0 + 32 * (wave & 3); qcol = PC_QC + 64 * qh; kcol = PC_KC + 64 * kvh; vcol = PC_VC + 64 * kvh; ocol = 768 + 64 * qh;
        kt_lo = 0; kt_hi = 32; }
    const size_t tokb = (size_t)b * SEQ;
    const int q = tw + r;
    bf16x8_t qf[4];
    const size_t qtok = tokb + (MODE == 2 ? rres + 16 * q : q);
#pragma unroll
    for (int s4 = 0; s4 < 4; ++s4) qf[s4] = *(const bf16x8_t*)(PROJ + qtok * NPROJ + qcol + 16 * s4 + 8 * hh);
    unsigned mask16 = 0u, mask4 = 0u;
    if (IS_A) {
#pragma unroll
        for (int e = 0; e < 16; ++e) { const int kr = (e & 3) + 8 * (e >> 2) + 4 * hh; const int d = kr - q;
            if ((d & 15) == 0) mask16 |= (1u << e) | (1u << (16 + e)); if ((d & 3) == 0) mask4 |= (1u << e) | (1u << (16 + e)); }
    }
    const int kkey = tid >> 3, kp = tid & 7;
    constexpr size_t KSTEP = (MODE == 2 ? 16 : 1) * (size_t)64 * NPROJ;
    const bf16* ksrc = PROJ + (tokb + (MODE == 2 ? rres + 16 * kkey : kkey)) * NPROJ + kcol + 8 * kp; const bf16* vsrc = VT + (size_t)kkey * (MODE == 2 ? 128 : SEQ) + 8 * kp;
    const int kdst = AT_K + kkey * 144 + kp * 16, vdst = AT_V + kkey * 144 + kp * 16;
    u32x4 kreg = *(const u32x4*)(ksrc + (size_t)kt_lo * KSTEP), vreg = *(const u32x4*)(vsrc + kt_lo * 64);
#define AT_WRITE(bufo) do { *(LAS u32x4*)(L + (bufo) + kdst) = kreg; *(LAS u32x4*)(L + (bufo) + vdst) = vreg; } while (0)
    AT_WRITE(0);
    f32x16_t o0, o1;
#pragma unroll
    for (int e = 0; e < 16; ++e) { o0[e] = 0.f; o1[e] = 0.f; }
    float m = -INFINITY, l = 0.f;
    float* part = (float*)((unsigned char*)(P.ws + WS_PROJ) + qtok * (size_t)(NPROJ * 2) + PC_QB * 2) + hA * 68;
    if (MODE == 1) { m = part[64]; l = hh == 0 ? part[65] : 0.f;
#pragma unroll
        for (int g4 = 0; g4 < 4; ++g4) { const f32x4 a = *(const f32x4*)(part + 8 * g4 + 4 * hh), c4 = *(const f32x4*)(part + 32 + 8 * g4 + 4 * hh);
#pragma unroll
            for (int e = 0; e < 4; ++e) { o0[4 * g4 + e] = a[e]; o1[4 * g4 + e] = c4[e]; } } }
    __syncthreads();
    for (int kt = kt_lo; kt < kt_hi; ++kt) {
        const int cur = ((kt - kt_lo) & 1) * AT_BUF;
        if (kt + 1 < kt_hi) { kreg = *(const u32x4*)(ksrc + (size_t)(kt + 1) * KSTEP); vreg = *(const u32x4*)(vsrc + (kt + 1) * 64); }
        const int k0 = kt * 64;
        const int dlo = k0 - (tw + 31), dhi = k0 + 63 - tw;
        const int dmin = dlo > 0 ? dlo : (dhi < 0 ? -dhi : 0), dmax = -dlo > dhi ? -dlo : dhi;
        if ((MODE != 1 || dmin <= 256) && !(MODE == 2 && wave >= 4)) {
            f32x16_t s0, s1;
#pragma unroll
            for (int e = 0; e < 16; ++e) { s0[e] = 0.f; s1[e] = 0.f; }
            const LAS unsigned char* kb = L + cur + AT_K + r * 144 + hh * 16;
#pragma unroll
            for (int s4 = 0; s4 < 4; ++s4) { const bf16x8_t a0 = *(const LAS bf16x8_t*)(kb + s4 * 32), a1 = *(const LAS bf16x8_t*)(kb + 32 * 144 + s4 * 32);
                s0 = __builtin_amdgcn_mfma_f32_32x32x16_bf16(a0, qf[s4], s0, 0, 0, 0); s1 = __builtin_amdgcn_mfma_f32_32x32x16_bf16(a1, qf[s4], s1, 0, 0, 0); }
            float w0[16], w1[16];
            if (IS_A) {
#pragma unroll
                for (int e = 0; e < 16; ++e) { const int kr = (e & 3) + 8 * (e >> 2) + 4 * hh;
                    { const int d = k0 + kr - q, ad = d < 0 ? -d : d; w0[e] = (ad <= 64 ? 1.f : 0.f) + (((mask4 >> e) & 1u) && ad <= 256 ? 1.f : 0.f); }
                    { const int d = k0 + 32 + kr - q, ad = d < 0 ? -d : d; w1[e] = (ad <= 64 ? 1.f : 0.f) + (((mask4 >> e) & 1u) && ad <= 256 ? 1.f : 0.f); } }
#pragma unroll
                for (int e = 0; e < 16; ++e) { if (w0[e] == 0.f) s0[e] = -INFINITY; if (w1[e] == 0.f) s1[e] = -INFINITY; }
            }
            if (MODE == 2 && dmax > 64) {
#pragma unroll
                for (int e = 0; e < 16; ++e) { const int kr = (e & 3) + 8 * (e >> 2) + 4 * hh;
                    { const int d = k0 + kr - q, ad = d < 0 ? -d : d; if (ad > 64) s0[e] = -INFINITY; }
                    { const int d = k0 + 32 + kr - q, ad = d < 0 ? -d : d; if (ad > 64) s1[e] = -INFINITY; } }
            }
            float mx = fmaxf(s0[0], s1[0]);
#pragma unroll
            for (int e = 1; e < 16; ++e) mx = fmaxf(mx, fmaxf(s0[e], s1[e]));
            mx = fmaxf(mx, __shfl_xor(mx, 32));
            const float mn = fmaxf(m, mx), mu = mn == -INFINITY ? 0.f : mn;
            const float alpha = __builtin_amdgcn_exp2f(m - mu);
            float ps = 0.f;
#pragma unroll
            for (int e = 0; e < 16; ++e) { float p0 = __builtin_amdgcn_exp2f(s0[e] - mu), p1 = __builtin_amdgcn_exp2f(s1[e] - mu); if (IS_A) { p0 *= w0[e]; p1 *= w1[e]; } s0[e] = p0; s1[e] = p1; ps += p0 + p1; }
            l = l * alpha + ps; m = mn;
#pragma unroll
            for (int e = 0; e < 16; ++e) { o0[e] *= alpha; o1[e] *= alpha; }
            bf16x8_t pb[2][2];
#pragma unroll
            for (int s2 = 0; s2 < 2; ++s2) {
                u32x4 w; w.x = cvtpk(s0[8 * s2], s0[8 * s2 + 1]); w.y = cvtpk(s0[8 * s2 + 2], s0[8 * s2 + 3]); w.z = cvtpk(s0[8 * s2 + 4], s0[8 * s2 + 5]); w.w = cvtpk(s0[8 * s2 + 6], s0[8 * s2 + 7]); pb[0][s2] = __builtin_bit_cast(bf16x8_t, w);
                w.x = cvtpk(s1[8 * s2], s1[8 * s2 + 1]); w.y = cvtpk(s1[8 * s2 + 2], s1[8 * s2 + 3]); w.z = cvtpk(s1[8 * s2 + 4], s1[8 * s2 + 5]); w.w = cvtpk(s1[8 * s2 + 6], s1[8 * s2 + 7]); pb[1][s2] = __builtin_bit_cast(bf16x8_t, w); }
            const LAS unsigned char* vq[8];
#pragma unroll
            for (int i = 0; i < 8; ++i) { vq[i] = L + cur + AT_V + r * 144 + hh * 8 + 16 * i; asm volatile("" : "+v"(vq[i])); }
#pragma unroll
            for (int u = 0; u < 2; ++u)
#pragma unroll
                for (int s2 = 0; s2 < 2; ++s2) { const int ki = 2 * (2 * u + s2);
                    const s16x4_t lo0 = *(const LAS s16x4_t*)(vq[ki]), hi0 = *(const LAS s16x4_t*)(vq[ki + 1]), lo1 = *(const LAS s16x4_t*)(vq[ki] + 32 * 144), hi1 = *(const LAS s16x4_t*)(vq[ki + 1] + 32 * 144);
                    const bf16x8_t a0 = (bf16x8_t){lo0[0], lo0[1], lo0[2], lo0[3], hi0[0], hi0[1], hi0[2], hi0[3]}, a1 = (bf16x8_t){lo1[0], lo1[1], lo1[2], lo1[3], hi1[0], hi1[1], hi1[2], hi1[3]};
                    o0 = __builtin_amdgcn_mfma_f32_32x32x16_bf16(a0, pb[u][s2], o0, 0, 0, 0); o1 = __builtin_amdgcn_mfma_f32_32x32x16_bf16(a1, pb[u][s2], o1, 0, 0, 0); }
        }
        if (kt + 1 < kt_hi) AT_WRITE(cur ^ AT_BUF);
        __syncthreads();
    }
#undef AT_WRITE
    const float lt = l + __shfl_xor(l, 32);
    if (MODE == 2) {
        if (wave < 4) {
#pragma unroll
            for (int g4 = 0; g4 < 4; ++g4) { *(f32x4*)(part + 8 * g4 + 4 * hh) = (f32x4){o0[4 * g4], o0[4 * g4 + 1], o0[4 * g4 + 2], o0[4 * g4 + 3]};
                *(f32x4*)(part + 32 + 8 * g4 + 4 * hh) = (f32x4){o1[4 * g4], o1[4 * g4 + 1], o1[4 * g4 + 2], o1[4 * g4 + 3]}; }
            if (hh == 0) { part[64] = m; part[65] = lt; } }
        return; }
    const float inv = __builtin_amdgcn_rcpf(lt);
    bf16* op = MIX + (tokb + q) * 1024 + ocol + 4 * hh;
#pragma unroll
    for (int g4 = 0; g4 < 4; ++g4) { u32x2 w; w.x = cvtpk(o0[4 * g4] * inv, o0[4 * g4 + 1] * inv); w.y = cvtpk(o0[4 * g4 + 2] * inv, o0[4 * g4 + 3] * inv); *(u32x2*)(op + 8 * g4) = w;
        w.x = cvtpk(o1[4 * g4] * inv, o1[4 * g4 + 1] * inv); w.y = cvtpk(o1[4 * g4 + 2] * inv, o1[4 * g4 + 3] * inv); *(u32x2*)(op + 32 + 8 * g4) = w; }
}
__device__ __forceinline__ void phase_b1(const Params& P, const Ctx& C, int L) {
    for (int item = blockIdx.x; item < 1024; item += gridDim.x) b1_item(P, C, item);
    for (int it = blockIdx.x; it < 512; it += gridDim.x) attn_item<2>(P, C, it);
}
__device__ __forceinline__ void phase_mix(const Params& P, const Ctx& C, int L, int rep) {
    unsigned* ctr = (unsigned*)(P.ws + WS_CTL) + 64 * L + 16 * rep;
    for (int chain = blockIdx.x; chain < 64; chain += gridDim.x) b2_chain(P, C, chain);
#if SPLIT_MX
    cg::this_grid().sync();
#endif
    for (;;) {
        if (C.tid == 0) *(LAS unsigned*)(C.lds + AT_ITEM) = atomicAdd(ctr, 1u);
        __syncthreads();
        const unsigned it = __builtin_amdgcn_readfirstlane(*(const LAS unsigned*)(C.lds + AT_ITEM));
        __syncthreads();
        if (it >= 512u) break;
        if (it < 256u) attn_item<1>(P, C, (int)it);
        else attn_item<0>(P, C, (int)it - 256);
    }
}

__device__ __forceinline__ void phase_finish(const Params& P, const Ctx& C, int L) {
    const bf16* OF = (const bf16*)(P.ws + WS_OF); const bf16* OB = (const bf16*)(P.ws + WS_OB); const bf16* PROJ = (const bf16*)(P.ws + WS_PROJ); bf16* MIX = (bf16*)(P.ws + WS_MIX);
    const f32x2_t on = *(const f32x2_t*)(P.in[I_ONORM] + L * 128 + 2 * C.lane);
    constexpr int FB = 8;
    for (int it0 = C.gw; it0 < M * 4; it0 += FB * C.ngw) {
        unsigned a[FB], bb[FB], zu[FB];
#pragma unroll
        for (int j = 0; j < FB; ++j) { const int it = it0 + j * C.ngw < M * 4 ? it0 + j * C.ngw : it0; const size_t tok = it >> 2; const int h = it & 3;
            a[j] = *(const unsigned*)(OF + tok * 512 + h * 128 + 2 * C.lane); bb[j] = *(const unsigned*)(OB + tok * 512 + h * 128 + 2 * C.lane); zu[j] = *(const unsigned*)(PROJ + tok * NPROJ + PC_ZB + h * 128 + 2 * C.lane); }
        float o0[FB], o1[FB], ss[FB];
#pragma unroll
        for (int j = 0; j < FB; ++j) { o0[j] = bflo(a[j]) + bflo(bb[j]); o1[j] = bfhi(a[j]) + bfhi(bb[j]); ss[j] = o0[j] * o0[j] + o1[j] * o1[j]; }
#pragma unroll
        for (int j = 0; j < FB; ++j) ss[j] = wave_sum(ss[j]);
#pragma unroll
        for (int j = 0; j < FB; ++j) { const int it = it0 + j * C.ngw; if (it < M * 4) { const size_t tok = it >> 2; const int h = it & 3;
            const float rs = __builtin_amdgcn_rsqf(ss[j] * (1.0f / 128.0f) + EPS); const float z0 = bflo(zu[j]), z1 = bfhi(zu[j]);
            *(unsigned*)(MIX + tok * 1024 + 256 + h * 128 + 2 * C.lane) = pk2(o0[j] * rs * on.x * z0 * __builtin_amdgcn_rcpf(1.0f + __expf(-z0)), o1[j] * rs * on.y * z1 * __builtin_amdgcn_rcpf(1.0f + __expf(-z1))); } }
    }
}

#ifndef SIMPLE_A
#define SIMPLE_A 0
#endif
#ifndef SPLIT_MX
#define SPLIT_MX 0
#endif
#ifndef REP
#define REP 0
#endif
#ifndef SKIP
#define SKIP 0
#endif
#define XB_TMO      128
#define XB_XCNT(j)  (256  + 64 * (j))
#define XB_XSUB(j)  (1280 + 64 * (j))
#define XB_XGEN(j)  (2304 + 64 * (j))
#define XB_TOP      3328
#define XB_TOPGEN   3392
#define XCD_BAR_WORDS 3456
#define XB_SPIN_CAP (1u << 18)

__device__ __forceinline__ unsigned xb_ld(unsigned* p)              { return __hip_atomic_load(p, __ATOMIC_RELAXED, __HIP_MEMORY_SCOPE_AGENT); }
__device__ __forceinline__ unsigned xb_add(unsigned* p, unsigned v) { return __hip_atomic_fetch_add(p, v, __ATOMIC_RELAXED, __HIP_MEMORY_SCOPE_AGENT); }
__device__ __forceinline__ unsigned xb_xcc_id() { return (unsigned)__builtin_amdgcn_s_getreg((3 << 11) | 20) & 0xFu; }
#define XB_SPIN(cond, bar) do { unsigned _sp = 0; while (cond) { __builtin_amdgcn_s_sleep(1); \
    if ((++_sp & 255u) == 0u) { if (xb_ld(&(bar)[XB_TMO])) break; if (_sp > XB_SPIN_CAP) { atomicAdd(&(bar)[XB_TMO], 1u); break; } } } } while (0)

struct XcdBarrier {
    unsigned* bar; unsigned x;
    volatile LAS unsigned* st;
};

__device__ __forceinline__ XcdBarrier xcd_barrier_post(unsigned* bar, volatile LAS unsigned* st) {
    XcdBarrier b; b.bar = bar; b.x = xb_xcc_id(); b.st = st;
    if (threadIdx.x == 0) (void)xb_add(&bar[XB_XCNT(b.x)], 1u);
    return b;
}
__device__ __forceinline__ void xcd_barrier_complete(unsigned* bar, unsigned x, unsigned& nloc, unsigned& nx) {
    const unsigned G = gridDim.x * gridDim.y * gridDim.z;
    unsigned sum, cnt, mine, sp = 0u;
    for (;;) {
        sum = 0u; cnt = 0u; mine = 0u;
#pragma unroll
        for (unsigned j = 0; j < 16; ++j) { const unsigned c = xb_ld(&bar[XB_XCNT(j)]); sum += c; cnt += (c > 0u) ? 1u : 0u; mine = (j == x) ? c : mine; }
        if (sum == G) break;
        __builtin_amdgcn_s_sleep(1);
        if ((++sp & 255u) == 0u) { if (xb_ld(&bar[XB_TMO])) break; if (sp > XB_SPIN_CAP) { atomicAdd(&bar[XB_TMO], 1u); break; } }
    }
    nloc = mine > 0u ? mine : 1u; nx = cnt > 0u ? cnt : 1u;
}

__device__ __forceinline__ void xcd_barrier(const XcdBarrier& b) {
    asm volatile("s_waitcnt vmcnt(0)" ::: "memory");
    __syncthreads();
    if (threadIdx.x == 0) {
        unsigned* bar = b.bar;
        __builtin_amdgcn_s_waitcnt(0);
        unsigned nloc = b.st[0], nx = b.st[1];
        if (nloc == 0u) { xcd_barrier_complete(bar, b.x, nloc, nx); b.st[0] = nloc; b.st[1] = nx; }
        const unsigned old = xb_add(&bar[XB_XSUB(b.x)], 1u);
        const unsigned gen = old / nloc;
        if (old + 1u == (gen + 1u) * nloc) {
            __builtin_amdgcn_fence(__ATOMIC_RELEASE, "agent");
            asm volatile("s_waitcnt vmcnt(0)" ::: "memory");
            const unsigned og = xb_add(&bar[XB_TOP], 1u);
            const unsigned tg = og / nx;
            if (og + 1u == (tg + 1u) * nx) xb_add(&bar[XB_TOPGEN], 1u);
            else XB_SPIN(xb_ld(&bar[XB_TOPGEN]) == tg, bar);
            __builtin_amdgcn_fence(__ATOMIC_ACQUIRE, "agent");
            xb_add(&bar[XB_XGEN(b.x)], 1u);
            asm volatile("s_waitcnt vmcnt(0)" ::: "memory");
        } else {
            XB_SPIN(xb_ld(&bar[XB_XGEN(b.x)]) == gen, bar);
            __builtin_amdgcn_fence(__ATOMIC_ACQUIRE, "agent");
            asm volatile("s_waitcnt vmcnt(0)" ::: "memory");
        }
    }
    __syncthreads();
}

__global__ void __launch_bounds__(512, 2) mega_fwd(Params P) {
    extern __shared__ __attribute__((aligned(16))) unsigned char lds[];
    cg::grid_group grid = cg::this_grid();
    { volatile LAS unsigned* st0 = (volatile LAS unsigned*)((LAS unsigned char*)lds + 147392); if (threadIdx.x < 2) st0[threadIdx.x] = 0u; }
    __syncthreads();
    XcdBarrier xbar = xcd_barrier_post((unsigned*)(P.ws + WS_CTL + 8192), (volatile LAS unsigned*)((LAS unsigned char*)lds + 147392));
    for (int ph = P.ph_lo; ph < P.ph_hi; ++ph) {
        const int L = ph / NPH, p = ph % NPH;
        const int nrep = ((REP >> p) & 1) ? 2 : 1;
        for (int rep = 0; rep < nrep; ++rep) {
        if (rep) xcd_barrier(xbar);
        int tid_ = threadIdx.x; asm volatile("" : "+v"(tid_));
        Ctx C; C.tid = tid_; C.lane = C.tid & 63; C.wave = __builtin_amdgcn_readfirstlane(C.tid >> 6); C.gw = blockIdx.x * 8 + C.wave; C.ngw = gridDim.x * 8; C.lds = (LAS unsigned char*)lds;
        unsigned char* ws = P.ws;
        if (p == 0) { if (!(SKIP & 1)) phase_n1(P, C, L); }
        else if (p == 1) { pg8::Gemm g{(const pg8::bf16_t*)(ws + WS_XN), (const pg8::bf16_t*)(ws + WS_WIN), M, NPROJ, DM}; pg8::StaticOrder S; S.init(M, NPROJ, gridDim.x, blockIdx.x);
            pg8::EpiStoreBf16 E{(pg8::bf16_t*)(ws + WS_PROJ), NPROJ}; pg8::gemm_phase<pg8::EpiStoreBf16, pg8::StaticOrder, true, true>(C.lds, g, S, E); }
        else if (p == 2) { if (!(SKIP & 2)) phase_prep(P, C, L); }
        else if (p == 3) { if (!(SKIP & 16)) phase_b1(P, C, L); }
        else if (p == 4) { if (!(SKIP & 4)) phase_mix(P, C, L, rep); }
        else if (p == 5) { if (!(SKIP & 8)) phase_finish(P, C, L); }
        else if (p == 6) { pg8::Gemm g{(const pg8::bf16_t*)(ws + WS_MIX), (const pg8::bf16_t*)(ws + WS_WO), M, DM, DM}; pg8::StaticOrder S; S.init(M, DM, gridDim.x, blockIdx.x);
            pg8::EpiResid E{L == 0 ? P.in[I_X] : P.out, (float*)(ws + WS_X1), DM}; pg8::gemm_phase<pg8::EpiResid, pg8::StaticOrder, true, true>(C.lds, g, S, E); }
        else if (p == 7) norm_rows<false>(P, C, L, (const float*)(ws + WS_X1), P.in[I_NORM2] + L * DM);
        else if (p == 8) { pg8::Gemm g{(const pg8::bf16_t*)(ws + WS_XN), (const pg8::bf16_t*)(ws + WS_WGU), M, NGU, DM}; pg8::StaticOrder S; S.init(M, NGU, gridDim.x, blockIdx.x);
            pg8::EpiSwiglu E{(pg8::bf16_t*)(ws + WS_PROJ), DFF}; pg8::gemm_phase<pg8::EpiSwiglu, pg8::StaticOrder, true, true>(C.lds, g, S, E); }
        else { pg8::Gemm g{(const pg8::bf16_t*)(ws + WS_PROJ), (const pg8::bf16_t*)(ws + WS_WD), M, DM, DFF}; pg8::StaticOrder S; S.init(M, DM, gridDim.x, blockIdx.x);
            pg8::EpiResid E{(const float*)(ws + WS_X1), P.out, DM}; pg8::gemm_phase<pg8::EpiResid, pg8::StaticOrder, true, true>(C.lds, g, S, E); }
        }
        if (ph + 1 < P.ph_hi) { if (ph == P.ph_lo) grid.sync(); else xcd_barrier(xbar); }
    }
}

#ifndef ONE_LAUNCH
#define ONE_LAUNCH 1
#endif
extern "C" void kernel_launch(void* const* d_in, const int* in_sizes, int n_in, void* d_out, int out_size, void* d_ws, size_t ws_size, hipStream_t stream) {
    static int grid = 0;
    if (!grid) {
        if (n_in != 15 || ws_size < WS_END) { fprintf(stderr, "kernel_launch: unexpected n_in %d / ws_size %zu (need %zu)\n", n_in, ws_size, (size_t)WS_END); return; }
        int dev = 0, cus = 0, per_cu = 0;
        hipGetDevice(&dev); hipDeviceGetAttribute(&cus, hipDeviceAttributeMultiprocessorCount, dev);
        hipFuncSetAttribute((const void*)mega_fwd, hipFuncAttributeMaxDynamicSharedMemorySize, LDS_BYTES);
        hipOccupancyMaxActiveBlocksPerMultiprocessor(&per_cu, mega_fwd, 512, LDS_BYTES);
        if (per_cu < 1) { fprintf(stderr, "kernel_launch: occupancy query says %d blocks per CU\n", per_cu); per_cu = 1; }
        grid = cus * per_cu;
    }
    Params p{};
    for (int i = 0; i < 15; ++i) p.in[i] = (const float*)d_in[i];
    p.out = (float*)d_out; p.ws = (unsigned char*)d_ws;
    hipMemsetAsync((char*)d_ws + WS_CTL, 0, 32768, stream);
#if ONE_LAUNCH
    p.ph_lo = 0; p.ph_hi = DEPTH * NPH;
    void* args[] = {&p};
    hipError_t e = hipLaunchCooperativeKernel((const void*)mega_fwd, dim3(grid), dim3(512), args, LDS_BYTES, stream);
    if (e != hipSuccess) fprintf(stderr, "cooperative launch failed: %s (grid %d)\n", hipGetErrorString(e), grid);
#else
    for (int ph = 0; ph < DEPTH * NPH; ++ph) { p.ph_lo = ph; p.ph_hi = ph + 1; hipLaunchKernelGGL(mega_fwd, dim3(grid), dim3(512), LDS_BYTES, stream, p); }
#endif
}
```
